# Optimizing an MI355X kernel written in HIP

```python
import math
import jax, jax.numpy as jnp
from jax import lax
import numpy as np

D_MODEL = 1024
BATCH = 8
SEQ = 4096
DEPTH = 4

GRID_W = 64
CTX_LEN = 256
N_GROUPS = 4
GROUP_W = D_MODEL // N_GROUPS
HEAD_DIM = 64
N_HEADS = GROUP_W // HEAD_DIM
NA_WIN_ROWS = 8
NA_WIN_COLS = 16
SGU_CHUNK = 128
DIFF_QK_DIM = HEAD_DIM // 2
ROPE_BASE = 10000.0
D_FF = 4 * D_MODEL
Q_BLOCK = 128
EPS = 1e-6
COL_FOURIER = 0
COL_NA = GROUP_W
COL_SGU = 4 * GROUP_W
COL_DIFF = 6 * GROUP_W
D_IN = 9 * GROUP_W

kernel_name = "hymba_style_fourier_na_sgu_diffattn_dit"


def rms_norm(x, g):
    x32 = x.astype(jnp.float32)
    y = x32 * lax.rsqrt(jnp.mean(x32 * x32, axis=-1, keepdims=True) + EPS)
    return (y * g.astype(jnp.float32)).astype(x.dtype)


def layer_norm(x, g, b):
    x32 = x.astype(jnp.float32)
    mu = jnp.mean(x32, axis=-1, keepdims=True)
    var = jnp.mean(jnp.square(x32 - mu), axis=-1, keepdims=True)
    y = (x32 - mu) * lax.rsqrt(var + EPS)
    return (y * g.astype(jnp.float32) + b.astype(jnp.float32)).astype(x.dtype)


def ada_params(cond, w, b):
    m = jax.nn.silu(cond) @ w + b
    return jnp.split(m, 6, axis=-1)


def modulate(h, shift, scale):
    return h * (1 + scale) + shift


def heads(t):
    return t.reshape(t.shape[0], t.shape[1], N_HEADS, HEAD_DIM)


def fourier_mix(a):
    bsz, n, _ = a.shape
    a4 = a.astype(jnp.float32).reshape(bsz, n, N_HEADS, GROUP_W // N_HEADS)
    f = jnp.fft.fft2(a4, axes=(1, 3), norm="ortho").real
    return f.reshape(bsz, n, GROUP_W).astype(a.dtype)


def dense_attention(q, k, v):
    s = jnp.einsum('bqhd,bkhd->bhqk', q, k).astype(jnp.float32) * (q.shape[-1] ** -0.5)
    p = jax.nn.softmax(s, axis=-1).astype(v.dtype)
    return jnp.einsum('bhqk,bkhd->bqhd', p, v)


def neighbourhood_attention(q, k, v, k_ctx, v_ctx, rpb, rows):
    bsz, n, h, dh = q.shape
    wr = min(NA_WIN_ROWS, rows)
    qg = q.reshape(bsz, rows, GRID_W, h, dh)
    kg = k.reshape(bsz, rows, GRID_W, h, dh)
    vg = v.reshape(bsz, rows, GRID_W, h, dh)
    r = jnp.arange(rows)
    row_start = jnp.clip(r - wr // 2, 0, rows - wr)
    key_rows = row_start[:, None] + jnp.arange(wr)[None, :]
    k_band = kg[:, key_rows]
    v_band = vg[:, key_rows]
    cidx = jnp.arange(GRID_W)
    col_start = jnp.clip(cidx - NA_WIN_COLS // 2, 0, GRID_W - NA_WIN_COLS)
    in_win = (cidx[None, :] >= col_start[:, None]) & (cidx[None, :] < col_start[:, None] + NA_WIN_COLS)
    dr = key_rows - r[:, None] + NA_WIN_ROWS - 1
    dc = jnp.clip(cidx[None, :] - cidx[:, None], 1 - NA_WIN_COLS, NA_WIN_COLS - 1) + NA_WIN_COLS - 1
    bias = rpb[:, dr[:, None, :, None], dc[None, :, None, :]]
    scale = dh ** -0.5
    s_loc = jnp.einsum('brqhd,brikhd->bhrqik', qg, k_band).astype(jnp.float32) * scale + bias.astype(jnp.float32)
    s_loc = jnp.where(in_win[:, None, :], s_loc, -jnp.inf)
    s_loc = s_loc.reshape(bsz, h, rows, GRID_W, wr * GRID_W)
    s_ctx = jnp.einsum('brqhd,blhd->bhrql', qg, k_ctx).astype(jnp.float32) * scale
    p = jax.nn.softmax(jnp.concatenate([s_loc, s_ctx], axis=-1), axis=-1).astype(v.dtype)
    p_loc = p[..., :wr * GRID_W].reshape(bsz, h, rows, GRID_W, wr, GRID_W)
    p_ctx = p[..., wr * GRID_W:]
    o = jnp.einsum('bhrqik,brikhd->brqhd', p_loc, v_band) + jnp.einsum('bhrql,blhd->brqhd', p_ctx, v_ctx)
    return o.reshape(bsz, n, h * dh)


def spatial_gating(uv, ln_g, ln_b, w_s, b_s):
    bsz, n, _ = uv.shape
    u, v = jnp.split(jax.nn.gelu(uv), 2, axis=-1)
    v = layer_norm(v, ln_g, ln_b)
    vc = v.reshape(bsz, n // SGU_CHUNK, SGU_CHUNK, N_HEADS, GROUP_W // N_HEADS)
    s = jnp.einsum('gpq,bnqgc->bnpgc', w_s, vc) + b_s.T[None, None, :, :, None]
    return u * s.reshape(bsz, n, GROUP_W)


def axial_rope(n):
    t = jnp.arange(n)
    rows = (t // GRID_W).astype(jnp.float32)
    cols = (t % GRID_W).astype(jnp.float32)
    n_freq = DIFF_QK_DIM // 4
    inv = ROPE_BASE ** (-jnp.arange(n_freq, dtype=jnp.float32) / n_freq)
    ang = jnp.concatenate([rows[:, None] * inv, cols[:, None] * inv], axis=-1)
    return jnp.cos(ang), jnp.sin(ang)


def apply_rope(x, cos, sin):
    nf = DIFF_QK_DIM // 4
    xs = x.reshape(x.shape[:-1] + (2, 2, nf))
    x1, x2 = xs[..., 0, :], xs[..., 1, :]
    c = cos.reshape(cos.shape[0], 1, 2, nf).astype(x.dtype)
    s = sin.reshape(sin.shape[0], 1, 2, nf).astype(x.dtype)
    out = jnp.stack([x1 * c - x2 * s, x1 * s + x2 * c], axis=-2)
    return out.reshape(x.shape)


def diff_attend(q1, q2, k1, k2, v, lam):
    scale = DIFF_QK_DIM ** -0.5
    s1 = jnp.einsum('bqhd,bkhd->bhqk', q1, k1).astype(jnp.float32) * scale
    s2 = jnp.einsum('bqhd,bkhd->bhqk', q2, k2).astype(jnp.float32) * scale
    p = jax.nn.softmax(s1, axis=-1) - lam * jax.nn.softmax(s2, axis=-1)
    return jnp.einsum('bhqk,bkhd->bqhd', p.astype(v.dtype), v)


def diff_latent(q, k, v, k_ctx, v_ctx, lam, cos, sin):
    bsz, n, h, _ = q.shape
    q1 = apply_rope(q[..., :DIFF_QK_DIM], cos, sin)
    q2 = apply_rope(q[..., DIFF_QK_DIM:], cos, sin)
    k1 = jnp.concatenate([apply_rope(k[..., :DIFF_QK_DIM], cos, sin), k_ctx[..., :DIFF_QK_DIM]], axis=1)
    k2 = jnp.concatenate([apply_rope(k[..., DIFF_QK_DIM:], cos, sin), k_ctx[..., DIFF_QK_DIM:]], axis=1)
    v_all = jnp.concatenate([v, v_ctx], axis=1)
    nb = n // Q_BLOCK

    def to_blocks(t):
        return t.reshape(bsz, nb, Q_BLOCK, h, DIFF_QK_DIM).swapaxes(0, 1)

    o = lax.map(lambda qb: diff_attend(qb[0], qb[1], k1, k2, v_all, lam), (to_blocks(q1), to_blocks(q2)))
    return o.swapaxes(0, 1).reshape(bsz, n, h, HEAD_DIM)


def diff_post(o, g, lam_init):
    y = rms_norm(o, g) * (1 - lam_init)
    return y.reshape(o.shape[0], o.shape[1], GROUP_W)


def sq_relu_mlp(h, w1, w2):
    return jnp.square(jax.nn.relu(h @ w1)) @ w2


def setup_inputs(seed: int = 0) -> dict:
    key = jax.random.key(seed)
    ks = jax.random.split(key, 24)
    f32 = jnp.float32

    def nrm(k, shape, s):
        return jax.random.normal(k, shape, f32) * s

    return {
        "x": nrm(ks[0], (BATCH, SEQ, D_MODEL), 1.0),
        "c": nrm(ks[1], (BATCH, D_MODEL), 1.0),
        "ctx": nrm(ks[2], (BATCH, CTX_LEN, D_MODEL), 1.0),
        "c_ctx": nrm(ks[3], (D_MODEL,), 1.0),
        "ada_w": nrm(ks[4], (DEPTH, D_MODEL, 6 * D_MODEL), 0.5 * D_MODEL ** -0.5),
        "ada_b": nrm(ks[5], (DEPTH, 6 * D_MODEL), 0.01),
        "norm1_g": 1.0 + nrm(ks[6], (DEPTH, D_MODEL), 0.02),
        "norm2_g": 1.0 + nrm(ks[7], (DEPTH, D_MODEL), 0.02),
        "w_in": nrm(ks[8], (DEPTH, D_MODEL, D_IN), D_MODEL ** -0.5),
        "w_out": nrm(ks[9], (DEPTH, D_MODEL, D_MODEL), D_MODEL ** -0.5),
        "na_rpb": nrm(ks[10], (DEPTH, N_HEADS, 2 * NA_WIN_ROWS - 1, 2 * NA_WIN_COLS - 1), 0.1),
        "sgu_ln_g": 1.0 + nrm(ks[11], (DEPTH, GROUP_W), 0.02),
        "sgu_ln_b": nrm(ks[12], (DEPTH, GROUP_W), 0.02),
        "sgu_w": nrm(ks[13], (DEPTH, N_HEADS, SGU_CHUNK, SGU_CHUNK), SGU_CHUNK ** -0.5),
        "sgu_b": 1.0 + nrm(ks[14], (DEPTH, N_HEADS, SGU_CHUNK), 0.02),
        "diff_lq1": nrm(ks[15], (DEPTH, DIFF_QK_DIM), 0.1),
        "diff_lk1": nrm(ks[16], (DEPTH, DIFF_QK_DIM), 0.1),
        "diff_lq2": nrm(ks[17], (DEPTH, DIFF_QK_DIM), 0.1),
        "diff_lk2": nrm(ks[18], (DEPTH, DIFF_QK_DIM), 0.1),
        "diff_subln_g": 1.0 + nrm(ks[19], (DEPTH, HEAD_DIM), 0.02),
        "w_ff1": nrm(ks[20], (DEPTH, D_MODEL, D_FF), D_MODEL ** -0.5),
        "w_ff2": nrm(ks[21], (DEPTH, D_FF, D_MODEL), D_FF ** -0.5),
        "final_g": 1.0 + nrm(ks[22], (D_MODEL,), 0.02),
    }


def reference(x, c, ctx, c_ctx, ada_w, ada_b, norm1_g, norm2_g, w_in, w_out, na_rpb, sgu_ln_g, sgu_ln_b,
              sgu_w, sgu_b, diff_lq1, diff_lk1, diff_lq2, diff_lk2, diff_subln_g, w_ff1, w_ff2, final_g):
    bsz, n, _ = x.shape
    rows = n // GRID_W
    cos, sin = axial_rope(n)
    cx = ctx
    gw = GROUP_W
    for l in range(DEPTH):
        last = l == DEPTH - 1
        sh1, sc1, g1, sh2, sc2, g2 = ada_params(c[:, None, :], ada_w[l], ada_b[l])
        csh1, csc1, cg1, csh2, csc2, cg2 = ada_params(c_ctx[None, None, :], ada_w[l], ada_b[l])
        h = modulate(rms_norm(x, norm1_g[l]), sh1, sc1)
        hc = modulate(rms_norm(cx, norm1_g[l]), csh1, csc1)
        w = w_in[l]
        p = h @ w
        if last:
            na_kv_c = hc @ w[:, COL_NA + gw:COL_NA + 3 * gw]
            df_kv_c = hc @ w[:, COL_DIFF + gw:COL_DIFF + 3 * gw]
        else:
            pc = hc @ w
            na_kv_c = pc[..., COL_NA + gw:COL_NA + 3 * gw]
            df_kv_c = pc[..., COL_DIFF + gw:COL_DIFF + 3 * gw]
        na_kc, na_vc = heads(na_kv_c[..., :gw]), heads(na_kv_c[..., gw:])
        df_kc, df_vc = heads(df_kv_c[..., :gw]), heads(df_kv_c[..., gw:])
        lam_init = 0.8 - 0.6 * math.exp(-0.3 * l)
        lam = (jnp.exp(jnp.sum(diff_lq1[l].astype(jnp.float32) * diff_lk1[l].astype(jnp.float32)))
               - jnp.exp(jnp.sum(diff_lq2[l].astype(jnp.float32) * diff_lk2[l].astype(jnp.float32))) + lam_init)

        y_a = fourier_mix(p[..., COL_FOURIER:COL_FOURIER + gw])
        y_b = neighbourhood_attention(heads(p[..., COL_NA:COL_NA + gw]), heads(p[..., COL_NA + gw:COL_NA + 2 * gw]),
                                      heads(p[..., COL_NA + 2 * gw:COL_NA + 3 * gw]), na_kc, na_vc, na_rpb[l], rows)
        y_c = spatial_gating(p[..., COL_SGU:COL_SGU + 2 * gw], sgu_ln_g[l], sgu_ln_b[l], sgu_w[l], sgu_b[l])
        o_d = diff_latent(heads(p[..., COL_DIFF:COL_DIFF + gw]), heads(p[..., COL_DIFF + gw:COL_DIFF + 2 * gw]),
                          heads(p[..., COL_DIFF + 2 * gw:COL_DIFF + 3 * gw]), df_kc, df_vc, lam, cos, sin)
        y_d = diff_post(o_d, diff_subln_g[l], lam_init)
        y = jnp.concatenate([y_a, y_b, y_c, y_d], axis=-1) @ w_out[l]

        if not last:
            yc_a = fourier_mix(pc[..., COL_FOURIER:COL_FOURIER + gw])
            yc_b = dense_attention(heads(pc[..., COL_NA:COL_NA + gw]), na_kc, na_vc).reshape(bsz, -1, gw)
            yc_c = spatial_gating(pc[..., COL_SGU:COL_SGU + 2 * gw], sgu_ln_g[l], sgu_ln_b[l], sgu_w[l], sgu_b[l])
            qc = heads(pc[..., COL_DIFF:COL_DIFF + gw])
            oc_d = diff_attend(qc[..., :DIFF_QK_DIM], qc[..., DIFF_QK_DIM:], df_kc[..., :DIFF_QK_DIM],
                               df_kc[..., DIFF_QK_DIM:], df_vc, lam)
            yc_d = diff_post(oc_d, diff_subln_g[l], lam_init)
            yc = jnp.concatenate([yc_a, yc_b, yc_c, yc_d], axis=-1) @ w_out[l]
            cx = cx + cg1 * yc
            hc2 = modulate(rms_norm(cx, norm2_g[l]), csh2, csc2)
            cx = cx + cg2 * sq_relu_mlp(hc2, w_ff1[l], w_ff2[l])

        x = x + g1 * y
        h2 = modulate(rms_norm(x, norm2_g[l]), sh2, sc2)
        x = x + g2 * sq_relu_mlp(h2, w_ff1[l], w_ff2[l])
    return rms_norm(x, final_g)
```

```cpp
#include <hip/hip_runtime.h>
#include <hip/hip_cooperative_groups.h>
#include <cstdio>
#include <cstdint>
namespace cg = cooperative_groups;
#ifndef ONE_LAUNCH
#define ONE_LAUNCH 1
#endif
#ifndef EN_F
#define EN_F 1
#endif
#ifndef EN_D
#define EN_D 1
#endif
#ifndef EN_N
#define EN_N 1
#endif
#ifndef EN_S
#define EN_S 1
#endif
#ifndef EN_P
#define EN_P 1
#endif
#ifndef EN_I
#define EN_I 1
#endif
#ifndef EN_R
#define EN_R 1
#endif
#ifndef EN_1
#define EN_1 1
#endif
#ifndef PROBE_S
#define PROBE_S -1
#endif
#ifndef PROBE_KIND
#define PROBE_KIND -1
#endif
#ifndef PROBE_P0
#define PROBE_P0 0
#endif
#ifndef PROBE_SYNC
#define PROBE_SYNC 0
#endif
namespace pg8 {
#define PG8_LAS __attribute__((address_space(3)))
typedef unsigned short bf16_t;
typedef short bf16x8 __attribute__((ext_vector_type(8)));
typedef float f32x4 __attribute__((ext_vector_type(4)));
typedef unsigned u32x4 __attribute__((ext_vector_type(4)));
constexpr int BM = 256, BK = 64, HALF = 128, HTB = HALF * BK * 2  , STAGE_BYTES = 8 * HTB, NXCD = 8, WGM = 8;

__host__ __device__ __forceinline__ int lds_byte(int r, int c) { const int st = (r >> 4) * 2 + (c >> 5), rr = r & 15, cc = c & 31, ob = rr * 64 + cc * 2; return st * 1024 + (ob ^ (((ob >> 9) & 1) << 5)); }
__host__ __device__ __forceinline__ void stage_rc(int b, int& R, int& C) { const int st = b / 1024, sb = b % 1024, swz = sb ^ (((sb >> 9) & 1) << 5); R = (st >> 1) * 16 + swz / 64; C = (st & 1) * 32 + (swz % 64) / 2; }
__host__ __device__ __forceinline__ int perm32(int rho) { const int n = rho >> 4, i = rho & 15; return 8 * (i >> 2) + 4 * n + (i & 3); }

struct Unit { int pm, pn, ko; };
struct Gemm { const bf16_t* A; const bf16_t* Bt; int M, N, K, ld; };

struct StaticOrder {
    int nM, nN, nwg, G, c;
    __host__ __device__ void init(int M, int N, int G_, int c_) { nM = M / BM; nN = N / BM; nwg = nM * nN; G = G_; c = c_; }
    __host__ __device__ bool next(int i, Unit& u) const {
        const long L = (long)i * G + c; if (L >= nwg) return false;
        int wgid = (int)L; { const int q = nwg / NXCD, r = nwg % NXCD, xcd = wgid % NXCD, off = wgid / NXCD; wgid = (xcd < r ? xcd * (q + 1) : r * (q + 1) + (xcd - r) * q) + off; }
        const int nig = WGM * nN, gid = wgid / nig, fm = gid * WGM, gsz = (nM - fm) < WGM ? (nM - fm) : WGM;
        u.pm = fm + ((wgid % nig) % gsz); u.pn = (wgid % nig) / gsz; u.ko = 0; return true;
    }
    __device__ __forceinline__ void a_ready(const Unit&) const {}
    __device__ __forceinline__ void done(const Unit&) const {}
};

template <class Epi, class Sched, bool ALIGN_EPI = false, bool SP2 = false>
__device__ __forceinline__ void gemm_phase(PG8_LAS unsigned char* lds, const Gemm g, const Sched& S, const Epi& E, const int tid) {
    const int wid = __builtin_amdgcn_readfirstlane(tid >> 6), lane = tid & 63, wr = wid >> 2, wc = wid & 3, fr = lane & 15, fq = lane >> 4;
    const int K = g.ld ? g.ld : g.K, nt = g.K / BK;
    unsigned voffA[2], voffB[2];
#pragma unroll
    for (int i = 0; i < 2; ++i) { int R, C; stage_rc(tid * 16 + i * 8192, R, C); const int Rb = Epi::PERM ? ((R & ~31) + perm32(R & 31)) : R;
        voffA[i] = (unsigned)(R * K + C) * 2u; voffB[i] = (unsigned)(Rb * K + C) * 2u; }
    const size_t kstep = (size_t)(BK * 2);
    const size_t hstep = (size_t)HALF * K * 2;
    const size_t tstep = 2 * hstep;
    const unsigned ldsw = (unsigned)wid * 1024u;
    const int aoff = lds_byte(wr * 64 + fr, fq * 8), boff = lds_byte(wc * 32 + fr, fq * 8);
#define PG8_SA(b, h) (((b) * 2 + (h)) * HTB)
#define PG8_SB(b, h) ((4 + (b) * 2 + (h)) * HTB)
#define PG8_STAGE(bufoff, gbase, voff) do { _Pragma("unroll") for (int _i = 0; _i < 2; ++_i) \
        __builtin_amdgcn_global_load_lds((const unsigned*)((const char*)(gbase) + (voff)[_i]), (PG8_LAS unsigned*)(lds + (bufoff) + ldsw + _i * 8192), 16, 0, 0); } while (0)
#define PG8_LDA(dst, b, h) do { _Pragma("unroll") for (int m = 0; m < 4; ++m) _Pragma("unroll") for (int k = 0; k < 2; ++k) dst[m][k] = *(const PG8_LAS bf16x8*)(lds + PG8_SA(b, h) + aoff + m * 2048 + k * 1024); } while (0)
#define PG8_LDB(dst, b, h) do { _Pragma("unroll") for (int n = 0; n < 2; ++n) _Pragma("unroll") for (int k = 0; k < 2; ++k) dst[n][k] = *(const PG8_LAS bf16x8*)(lds + PG8_SB(b, h) + boff + n * 2048 + k * 1024); } while (0)
#define PG8_MMA(ai, bj, At, Bt) do { __builtin_amdgcn_s_setprio(1); _Pragma("unroll") for (int m = 0; m < 4; ++m) _Pragma("unroll") for (int n = 0; n < 2; ++n) _Pragma("unroll") for (int k = 0; k < 2; ++k) \
        acc[ai][bj][m][n] = __builtin_amdgcn_mfma_f32_16x16x32_bf16(Bt[n][k], At[m][k], acc[ai][bj][m][n], 0, 0, 0); __builtin_amdgcn_s_setprio(0); } while (0)
#define PG8_WAIT_V(n) asm volatile("s_waitcnt vmcnt(" #n ")" ::: "memory")
#define PG8_WAIT_L(n) asm volatile("s_waitcnt lgkmcnt(" #n ")" ::: "memory")
#define PG8_BAR __builtin_amdgcn_s_barrier()
#define PG8_SCHED __builtin_amdgcn_sched_barrier(0)
    Unit cur, nxt; int ui = 0;
    if (!S.next(0, cur)) return;
    f32x4 acc[2][2][4][2];
#pragma unroll
    for (int a = 0; a < 2; ++a)
#pragma unroll
        for (int b = 0; b < 2; ++b)
#pragma unroll
            for (int m = 0; m < 4; ++m)
#pragma unroll
                for (int n = 0; n < 2; ++n) acc[a][b][m][n] = (f32x4){0.f, 0.f, 0.f, 0.f};
    bf16x8 At[4][2], B0[2][2], B1[2][2];
    const char* cA = (const char*)g.A + (size_t)cur.pm * tstep + cur.ko; const char* cB = (const char*)g.Bt + (size_t)cur.pn * tstep + cur.ko;
    S.a_ready(cur);
    if constexpr (SP2) {
        PG8_STAGE(PG8_SB(0, 0), cB, voffB); PG8_STAGE(PG8_SB(0, 1), cB + hstep, voffB); PG8_STAGE(PG8_SA(0, 0), cA, voffA); PG8_STAGE(PG8_SA(0, 1), cA + hstep, voffA);
        if (wr == 1) PG8_BAR;
        PG8_WAIT_V(2); PG8_BAR;
        PG8_STAGE(PG8_SB(1, 0), cB + kstep, voffB); PG8_STAGE(PG8_SA(1, 0), cA + kstep, voffA); PG8_STAGE(PG8_SB(1, 1), cB + hstep + kstep, voffB);
        PG8_WAIT_V(6); PG8_BAR;
    } else {
        PG8_STAGE(PG8_SB(0, 0), cB, voffB); PG8_STAGE(PG8_SA(0, 0), cA, voffA); PG8_STAGE(PG8_SB(0, 1), cB + hstep, voffB); PG8_STAGE(PG8_SA(0, 1), cA + hstep, voffA);
        if (wr == 1) PG8_BAR;
        PG8_WAIT_V(4); PG8_BAR;
        PG8_STAGE(PG8_SB(1, 0), cB + kstep, voffB); PG8_STAGE(PG8_SA(1, 0), cA + kstep, voffA); PG8_STAGE(PG8_SB(1, 1), cB + hstep + kstep, voffB);
        PG8_WAIT_V(6); PG8_BAR;
    }
    for (;;) {
        const bool has_next = S.next(ui + 1, nxt);
        const char* nA = has_next ? (const char*)g.A + (size_t)nxt.pm * tstep + nxt.ko : cA; const char* nB = has_next ? (const char*)g.Bt + (size_t)nxt.pn * tstep + nxt.ko : cB;
        for (int t = 0; t < nt; t += 2) {
            const bool last = (t == nt - 2);
            const char* a1 = cA + (size_t)(t + 1) * kstep;
            const char* a2 = last ? nA : cA + (size_t)(t + 2) * kstep; const char* b2 = last ? nB : cB + (size_t)(t + 2) * kstep;
            const char* a3 = a2 + kstep; const char* b3 = b2 + kstep;
            if (last && has_next) S.a_ready(nxt);
            if constexpr (SP2) {
            PG8_LDB(B0, 0, 0); PG8_LDB(B1, 0, 1); PG8_SCHED; PG8_LDA(At, 0, 0); PG8_STAGE(PG8_SA(1, 1), a1 + hstep, voffA);
            PG8_WAIT_V(8); PG8_WAIT_L(0); PG8_BAR; PG8_MMA(0, 0, At, B0); PG8_MMA(0, 1, At, B1); PG8_BAR; PG8_SCHED;
            PG8_LDA(At, 0, 1); PG8_STAGE(PG8_SB(0, 0), b2, voffB); PG8_STAGE(PG8_SB(0, 1), b2 + hstep, voffB); PG8_STAGE(PG8_SA(0, 0), a2, voffA);
            PG8_WAIT_V(8); PG8_WAIT_L(0); PG8_BAR; PG8_MMA(1, 0, At, B0); PG8_MMA(1, 1, At, B1); PG8_BAR; PG8_SCHED;
            PG8_LDB(B0, 1, 0); PG8_LDB(B1, 1, 1); PG8_SCHED; PG8_LDA(At, 1, 0); PG8_STAGE(PG8_SA(0, 1), a2 + hstep, voffA);
            PG8_WAIT_V(8); PG8_WAIT_L(0); PG8_BAR; PG8_MMA(0, 0, At, B0); PG8_MMA(0, 1, At, B1); PG8_BAR; PG8_SCHED;
            PG8_LDA(At, 1, 1); PG8_STAGE(PG8_SB(1, 0), b3, voffB); PG8_STAGE(PG8_SB(1, 1), b3 + hstep, voffB); PG8_STAGE(PG8_SA(1, 0), a3, voffA);
            PG8_WAIT_V(8); PG8_WAIT_L(0); PG8_BAR; PG8_MMA(1, 0, At, B0); PG8_MMA(1, 1, At, B1); PG8_BAR; PG8_SCHED;
            } else {
            PG8_LDB(B0, 0, 0); PG8_SCHED; PG8_LDA(At, 0, 0); PG8_STAGE(PG8_SA(1, 1), a1 + hstep, voffA);
            PG8_WAIT_L(8); PG8_BAR; PG8_WAIT_L(0); PG8_MMA(0, 0, At, B0); PG8_BAR; PG8_SCHED;
            PG8_LDB(B1, 0, 1); PG8_STAGE(PG8_SB(0, 0), b2, voffB);
            PG8_BAR; PG8_WAIT_L(0); PG8_MMA(0, 1, At, B1); PG8_BAR;
            PG8_LDA(At, 0, 1); PG8_STAGE(PG8_SA(0, 0), a2, voffA);
            PG8_BAR; PG8_WAIT_L(0); PG8_MMA(1, 0, At, B0); PG8_BAR; PG8_SCHED;
            PG8_STAGE(PG8_SB(0, 1), b2 + hstep, voffB);
            PG8_WAIT_V(6); PG8_BAR; PG8_MMA(1, 1, At, B1); PG8_BAR;
            PG8_LDB(B0, 1, 0); PG8_SCHED; PG8_LDA(At, 1, 0); PG8_STAGE(PG8_SA(0, 1), a2 + hstep, voffA);
            PG8_WAIT_L(8); PG8_BAR; PG8_WAIT_L(0); PG8_MMA(0, 0, At, B0); PG8_BAR; PG8_SCHED;
            PG8_LDB(B1, 1, 1); PG8_STAGE(PG8_SB(1, 0), b3, voffB);
            PG8_BAR; PG8_WAIT_L(0); PG8_MMA(0, 1, At, B1); PG8_BAR;
            PG8_LDA(At, 1, 1); PG8_STAGE(PG8_SA(1, 0), a3, voffA);
            PG8_BAR; PG8_WAIT_L(0); PG8_MMA(1, 0, At, B0); PG8_BAR; PG8_SCHED;
            PG8_STAGE(PG8_SB(1, 1), b3 + hstep, voffB);
            PG8_WAIT_V(6); PG8_BAR; PG8_MMA(1, 1, At, B1); PG8_BAR;
            }
        }
        if constexpr (ALIGN_EPI) { if (wr == 0) PG8_BAR; }
        if constexpr (!Epi::AFTER_DRAIN) { E(acc, cur, wr, wc, fr, fq); S.done(cur); }
        if (!has_next) break;
#pragma unroll
        for (int a = 0; a < 2; ++a)
#pragma unroll
            for (int b = 0; b < 2; ++b)
#pragma unroll
                for (int m = 0; m < 4; ++m)
#pragma unroll
                    for (int n = 0; n < 2; ++n) acc[a][b][m][n] = (f32x4){0.f, 0.f, 0.f, 0.f};
        cur = nxt; cA = nA; cB = nB; ++ui;
        if constexpr (ALIGN_EPI) { if (wr == 1) PG8_BAR; }
    }
    PG8_WAIT_V(0);
    if constexpr (!ALIGN_EPI) { if (wr == 0) PG8_BAR; }
    PG8_BAR;
    if constexpr (Epi::AFTER_DRAIN) { E.fused(acc, cur, wr, wc, fr, fq, lds, wid, lane); S.done(cur); }
#undef PG8_SA
#undef PG8_SB
#undef PG8_STAGE
#undef PG8_LDA
#undef PG8_LDB
#undef PG8_MMA
#undef PG8_WAIT_V
#undef PG8_WAIT_L
#undef PG8_BAR
#undef PG8_SCHED
}
}
#define DI __device__ __forceinline__
#define LAS __attribute__((address_space(3)))
typedef unsigned short bf16_t;
typedef short bf16x8 __attribute__((ext_vector_type(8)));
typedef short s16x4 __attribute__((ext_vector_type(4)));
typedef float f32x4 __attribute__((ext_vector_type(4)));
typedef float f32x2 __attribute__((ext_vector_type(2)));
typedef float f32x16 __attribute__((ext_vector_type(16)));
typedef unsigned u32x4 __attribute__((ext_vector_type(4)));
typedef unsigned u32x2 __attribute__((ext_vector_type(2)));
typedef __bf16 bf2_t __attribute__((ext_vector_type(2)));
DI unsigned pk2(float lo, float hi) { f32x2 v = {lo, hi}; return __builtin_bit_cast(unsigned, __builtin_convertvector(v, bf2_t)); }
DI bf16_t f2bf(float x) { return (bf16_t)(pk2(x, 0.f) & 0xffffu); }
DI float bf2f(unsigned v) { return __builtin_bit_cast(float, v << 16); }
#define MFMA32(a, b, c) __builtin_amdgcn_mfma_f32_32x32x16_bf16((a), (b), (c), 0, 0, 0)
DI float ex2(float x) { return __builtin_amdgcn_exp2f(x); }
DI float xor32(float v) { return __shfl_xor(v, 32); }

constexpr int DM = 1024, NB = 8, SEQ = 4096, DEPTH = 4, CTX = 256, DFF = 4096;
constexpr int ML = NB * SEQ, MC = NB * CTX, MT = ML + MC, NIN = 2560, KV = SEQ + CTX;
constexpr float LOG2E = 1.4426950408889634f;
constexpr size_t MiB = 1u << 20;
constexpr size_t WS_CTL = 0, WS_LAM = 32768, WS_MOD = 1 * MiB, WS_CSC = 2 * MiB, WS_WIN = 4 * MiB, WS_WOUT = 24 * MiB, WS_WFF1 = 32 * MiB,
                 WS_WFF2 = 64 * MiB, WS_CS = 96 * MiB, WS_H = 160 * MiB, WS_CX = 228 * MiB, WS_U = 236 * MiB;
constexpr size_t WS_PQT = WS_U, WS_PQTC = WS_U + 32 * MiB, WS_NAQ = WS_U + 34 * MiB, WS_NAK = WS_U + 51 * MiB, WS_SGU = WS_U + 68 * MiB,
                 WS_SGV = WS_U + 85 * MiB, WS_DFQ = WS_U + 102 * MiB, WS_DFK = WS_U + 119 * MiB, WS_NAVT = WS_U + 136 * MiB, WS_DFVT = WS_U + 153 * MiB;
constexpr size_t WS_END = WS_U + 272 * MiB;
constexpr size_t WS_SGW = 2 * MiB + 256 * 1024;
constexpr size_t WS_PB = WS_CS + 1 * MiB;
constexpr int LDS_BYTES = 147456, MISC_OFF = 131072, ROPE_OFF = MISC_OFF + 1024, RPB_OFF = MISC_OFF + 5120;

struct Args { const float* in[23]; float* out; unsigned char* ws; int ph_lo, ph_hi; };

DI void transpose_tile(const Args& A, int l, int r, LAS unsigned char* lds, const int tid) {
    const int lane = tid & 63, wid = __builtin_amdgcn_readfirstlane(tid >> 6);
    unsigned char* ws = A.ws;
    LAS float* big = (LAS float*)(lds + 53248);
    const float* src; bf16_t* dst; int K, N, kt, nt;
    if (r < 128) { K = 1024; N = 2304; kt = r >> 3; nt = r & 7; src = A.in[8] + (size_t)l * 1024 * 2304 + 256; dst = (bf16_t*)(ws + WS_WIN) + (size_t)l * NIN * 1024 + 512 * 1024; }
    else if (r < 192) { r -= 128; K = 1024; N = 1024; kt = r >> 2; nt = r & 3; src = A.in[9] + (size_t)l * 1024 * 1024; dst = (bf16_t*)(ws + WS_WOUT) + (size_t)l * 1024 * 1024; }
    else if (r < 448) { r -= 192; K = 1024; N = 4096; kt = r >> 4; nt = r & 15; src = A.in[20] + (size_t)l * 1024 * 4096; dst = (bf16_t*)(ws + WS_WFF1) + (size_t)l * 4096 * 1024; }
    else { r -= 448; K = 4096; N = 1024; kt = r >> 2; nt = r & 3; src = A.in[21] + (size_t)l * 4096 * 1024; dst = (bf16_t*)(ws + WS_WFF2) + (size_t)l * 1024 * 4096; }
    float v[32];
    const float* sp = src + (size_t)(kt * 64 + (tid >> 6)) * N + nt * 256 + lane;
#pragma unroll
    for (int i = 0; i < 8; ++i)
#pragma unroll
        for (int j = 0; j < 4; ++j) v[i * 4 + j] = sp[(size_t)(8 * i) * N + 64 * j];
    __syncthreads();
#pragma unroll
    for (int i = 0; i < 8; ++i)
#pragma unroll
        for (int j = 0; j < 4; ++j) big[(wid + 8 * i) * 257 + 64 * j + lane] = v[i * 4 + j];
    __syncthreads();
#pragma unroll 4
    for (int i = 0; i < 32; ++i) { const int nn = wid + 8 * i; dst[(size_t)(nt * 256 + nn) * K + kt * 64 + lane] = f2bf(big[lane * 257 + nn]); }
}

DI void phase_prologue(const Args& A, LAS unsigned char* lds, const int tid, const int parts = 15) {
    const int lane = tid & 63, wid = __builtin_amdgcn_readfirstlane(tid >> 6);
    unsigned char* ws = A.ws;
    LAS float* silu_t = (LAS float*)lds;
    LAS float* cos_t = (LAS float*)(lds + 36864);
    LAS float* tile = (LAS float*)(lds + 53248);
    LAS float* red = (LAS float*)(lds + 69888);
    for (int i = tid; i < 9 * 1024; i += 512) { const int r = i >> 10, k = i & 1023; const float v = r < 8 ? A.in[1][r * 1024 + k] : A.in[3][k]; silu_t[i] = v / (1.f + expf(-v)); }
    for (int i = tid; i < 4096; i += 512) cos_t[i] = cospif((float)i * (1.f / 2048.f));
    LAS float* c64 = (LAS float*)(lds + 122880);
    if (tid < 64) { c64[tid] = cospif((float)tid * (1.f / 32.f)); c64[64 + tid] = sinpif((float)tid * (1.f / 32.f)); }
    if (blockIdx.x == 0 && tid < DEPTH) {
        const int l = tid; float s1 = 0.f, s2 = 0.f;
        for (int i = 0; i < 32; ++i) { s1 += A.in[15][l * 32 + i] * A.in[16][l * 32 + i]; s2 += A.in[17][l * 32 + i] * A.in[18][l * 32 + i]; }
        const float lam_init = 0.8f - 0.6f * expf(-0.3f * (float)l);
        float* lt = (float*)(ws + WS_LAM); lt[2 * l] = expf(s1) - expf(s2) + lam_init; lt[2 * l + 1] = 1.f - lam_init;
    }
    __syncthreads();
    {
        const float* src = A.in[13]; bf16_t* dst = (bf16_t*)(ws + WS_SGW);
        for (int i = blockIdx.x * 512 + tid; i < DEPTH * 4 * 128 * 128 / 2; i += gridDim.x * 512) ((unsigned*)dst)[i] = pk2(src[2 * i], src[2 * i + 1]);
    }
    {
        const f32x4* src = (const f32x4*)A.in[2]; f32x4* dst = (f32x4*)(ws + WS_CX);
        for (int i = blockIdx.x * 512 + tid; i < MC * DM / 4; i += gridDim.x * 512) dst[i] = src[i];
    }
    bf16_t* CS = (bf16_t*)(ws + WS_CS);
    if (parts & 1)
    for (int rr = blockIdx.x; rr < 512; rr += gridDim.x) {
        const int pm = rr >> 8, row = rr & 255, cs = row >> 7, k1 = 128 * pm + (row & 127), pq = tid >> 8, n1 = tid & 255;
        const int t = ((n1 * k1) & 255) * 16;
        const float cv = cos_t[t], sv = cos_t[(t + 3072) & 4095];
        CS[(size_t)rr * 512 + tid] = f2bf(cs == 0 ? (pq == 0 ? cv : sv) : (pq == 0 ? -sv : cv));
    }
    bf16_t* CSc = (bf16_t*)(ws + WS_CSC);
    for (int k = blockIdx.x; k < 256; k += gridDim.x) { const int j = tid, jj = j & 255; int t = ((k * jj) & 255) * 16; if (j >= 256) t = (t + 3072) & 4095; CSc[k * 512 + j] = f2bf(cos_t[t]); }
    if (parts & 2)
    for (int it = blockIdx.x; it < 256; it += gridDim.x) {
        const int l = it >> 6, h = (it >> 4) & 3, kb = it & 15;
        const float* src = A.in[8] + (size_t)l * 1024 * 2304 + (size_t)(kb * 64) * 2304 + h * 64;
        __syncthreads();
#pragma unroll
        for (int i = 0; i < 8; ++i) { const int kk = wid + 8 * i; tile[kk * 65 + lane] = src[(size_t)kk * 2304 + lane]; }
        __syncthreads();
        bf16_t* dst = (bf16_t*)(ws + WS_WIN) + (size_t)l * NIN * 1024;
        const int m = lane;
#pragma unroll 1
        for (int i = 0; i < 8; ++i) {
            const int kk = wid + 8 * i; float P = 0.f, Q = 0.f;
#pragma unroll 4
            for (int c = 0; c < 64; ++c) { const float w = tile[kk * 65 + c]; const int t = (c * m) & 63; P += w * c64[t]; Q += w * c64[64 + t]; }
            dst[(size_t)(h * 64 + m) * 1024 + kb * 64 + kk] = f2bf(P); dst[(size_t)(256 + h * 64 + m) * 1024 + kb * 64 + kk] = f2bf(-Q);
        }
    }
    if (parts & 4)
    for (int it = blockIdx.x; it < 704; it += gridDim.x) transpose_tile(A, 0, it, lds, tid);
    float* MOD = (float*)(ws + WS_MOD);
    if (parts & 8)
    for (int it = blockIdx.x; it < 4 * 192; it += gridDim.x) {
        const int l = it / 192, nb = it % 192, cl = lane & 31, kp = lane >> 5;
        const float* w = A.in[4] + (size_t)l * 1024 * 6144 + nb * 32 + cl;
        float acc[9];
#pragma unroll
        for (int r = 0; r < 9; ++r) acc[r] = 0.f;
#pragma unroll 16
        for (int k = wid * 128 + kp; k < wid * 128 + 128; k += 2) {
            const float wv = w[(size_t)k * 6144];
#pragma unroll
            for (int r = 0; r < 9; ++r) acc[r] += silu_t[r * 1024 + k] * wv;
        }
        __syncthreads();
#pragma unroll
        for (int r = 0; r < 9; ++r) red[(wid * 9 + r) * 64 + lane] = acc[r];
        __syncthreads();
        for (int i = tid; i < 9 * 32; i += 512) {
            const int r = i >> 5, nn = i & 31; float sm = 0.f;
            for (int w8 = 0; w8 < 8; ++w8) sm += red[(w8 * 9 + r) * 64 + nn] + red[(w8 * 9 + r) * 64 + 32 + nn];
            MOD[(size_t)(l * 9 + r) * 6144 + nb * 32 + nn] = sm + A.in[5][l * 6144 + nb * 32 + nn];
        }
    }
}

DI float wave_sum(float v) {
#pragma unroll
    for (int o = 32; o > 0; o >>= 1) v += __shfl_xor(v, o);
    return v;
}
DI void phase_norm(const Args& A, int l, int which, int nrows, const float* srcL, float* srcC, const float* pgate, const int tid) {
    const int lane = tid & 63, wid = tid >> 6;
    const float* g = A.in[which ? 7 : 6] + l * 1024;
    const float* mod = (const float*)(A.ws + WS_MOD) + (size_t)l * 9 * 6144;
    bf16_t* H = (bf16_t*)(A.ws + WS_H);
    const int stride = gridDim.x * 8;
    constexpr int NR = 4;
    for (int row0 = blockIdx.x * 8 + wid; row0 < nrows; row0 += NR * stride) {
        f32x4 v[NR][4]; float ss[NR];
#pragma unroll
        for (int u = 0; u < NR; ++u) {
            const int row = min(row0 + u * stride, nrows - 1);
            const float* src = row < ML ? srcL + (size_t)row * 1024 : srcC + (size_t)(row - ML) * 1024;
            ss[u] = 0.f;
#pragma unroll
            for (int i = 0; i < 4; ++i) v[u][i] = *(const f32x4*)(src + i * 256 + lane * 4);
            if (pgate != nullptr && row >= ML) {
                const float* pb = (const float*)(A.ws + WS_PB) + (size_t)(row - ML) * 1024;
#pragma unroll
                for (int i = 0; i < 4; ++i) {
                    const int k = i * 256 + lane * 4;
                    const f32x4 p = *(const f32x4*)(pb + k) + *(const f32x4*)(pb + (size_t)MC * 1024 + k) + *(const f32x4*)(pb + (size_t)2 * MC * 1024 + k) + *(const f32x4*)(pb + (size_t)3 * MC * 1024 + k);
                    v[u][i] = v[u][i] + *(const f32x4*)(pgate + k) * p;
                    if (row0 + u * stride < nrows) *(f32x4*)(srcC + (size_t)(row - ML) * 1024 + k) = v[u][i];
                }
            }
#pragma unroll
            for (int i = 0; i < 4; ++i) ss[u] += v[u][i].x * v[u][i].x + v[u][i].y * v[u][i].y + v[u][i].z * v[u][i].z + v[u][i].w * v[u][i].w;
        }
#pragma unroll
        for (int u = 0; u < NR; ++u) {
            const int row = row0 + u * stride;
            if (row < nrows) {
                const int bidx = row < ML ? (row >> 12) : 8;
                const float* sh = mod + bidx * 6144 + (which ? 3 : 0) * 1024; const float* sc = sh + 1024;
                const float r = rsqrtf(wave_sum(ss[u]) * (1.f / 1024.f) + 1e-6f);
#pragma unroll
                for (int i = 0; i < 4; ++i) {
                    const int k = i * 256 + lane * 4;
                    const f32x4 gv = *(const f32x4*)(g + k), sv = *(const f32x4*)(sc + k), hv = *(const f32x4*)(sh + k);
                    const f32x4 y = v[u][i] * r * gv * (1.f + sv) + hv;
                    u32x2 o; o.x = pk2(y.x, y.y); o.y = pk2(y.z, y.w);
                    *(u32x2*)(H + (size_t)row * 1024 + k) = o;
                }
            }
        }
    }
}
DI void phase_final(const Args& A, const int tid) {
    const int lane = tid & 63, wid = tid >> 6;
    const float* g = A.in[22];
    for (int row = blockIdx.x * 8 + wid; row < ML; row += gridDim.x * 8) {
        float* p = A.out + (size_t)row * 1024;
        f32x4 v[4]; float ss = 0.f;
#pragma unroll
        for (int i = 0; i < 4; ++i) { v[i] = *(const f32x4*)(p + i * 256 + lane * 4); ss += v[i].x * v[i].x + v[i].y * v[i].y + v[i].z * v[i].z + v[i].w * v[i].w; }
        ss = wave_sum(ss);
        const float r = rsqrtf(ss * (1.f / 1024.f) + 1e-6f);
#pragma unroll
        for (int i = 0; i < 4; ++i) { const int k = i * 256 + lane * 4; *(f32x4*)(p + k) = v[i] * r * *(const f32x4*)(g + k); }
    }
}
struct OneUnit {
    pg8::Unit u;
    DI bool next(int i, pg8::Unit& o) const { if (i) return false; o = u; return true; }
    DI void a_ready(const pg8::Unit&) const {}
    DI void done(const pg8::Unit&) const {}
};
DI float gelu_tanh(float x) { const float y = 0.7978845608028654f * (x + 0.044715f * x * x * x); return x * __builtin_amdgcn_rcpf(1.f + ex2(-2.f * LOG2E * y)); }

struct EpiIn {
    static constexpr bool PERM = true, AFTER_DRAIN = false;
    unsigned char* ws; const LAS float* rope;
    DI void operator()(const pg8::f32x4 (&acc)[2][2][4][2], const pg8::Unit& u, int wr, int wc, int fr, int fq) const {
        const int pm = u.pm, pn = u.pn; const bool lat = pm < 128; const int b = lat ? (pm >> 4) : (pm - 128);
        const int r0 = pm * 256 + wr * 64 + fr, c0 = wc * 32 + 8 * fq;
        const int p0 = lat ? (r0 & 4095) : (r0 - ML - b * 256);
        if (pn <= 1 || pn == 4 || pn == 9) {
            bf16_t* base; unsigned rs; int poff;
            if (pn <= 1 && lat) {
                bf16_t* zt = (bf16_t*)(ws + WS_PQT);
                const int n2 = fr, n1b = (pm & 15) * 16 + wr * 4;
#pragma unroll
                for (int ai = 0; ai < 2; ++ai)
#pragma unroll
                    for (int bj = 0; bj < 2; ++bj) {
                        const int hmhi = 2 * wc + 8 * bj + (fq >> 1);
#pragma unroll
                        for (int e = 0; e < 8; ++e) {
                            const int hmlo = 8 * (fq & 1) + e;
                            const int c = 128 * (n2 >> 3) + 4 * ((n2 >> 2) & 1) + (n2 & 3) + 32 * (hmlo >> 2) + 8 * (hmlo & 3);
                            u32x2 w;
                            w.x = pk2(acc[ai][bj][0][e >> 2][e & 3], acc[ai][bj][1][e >> 2][e & 3]); w.y = pk2(acc[ai][bj][2][e >> 2][e & 3], acc[ai][bj][3][e >> 2][e & 3]);
                            *(u32x2*)(zt + ((unsigned)((b * 16 + hmhi) * 256 + c) * 512u + (unsigned)(pn * 256 + n1b + 8 * ai))) = w;
                        }
                        __builtin_amdgcn_sched_barrier(0);
                    }
                return;
            }
            if (pn <= 1) { base = (bf16_t*)(ws + WS_PQTC) + (size_t)b * 256 * 512; rs = 512; poff = 256 * pn; }
            else { base = (bf16_t*)(ws + (pn == 4 ? WS_NAVT : WS_DFVT)) + (size_t)b * 256 * KV; rs = KV; poff = lat ? 0 : 4096; }
#pragma unroll
            for (int ai = 0; ai < 2; ++ai)
#pragma unroll
                for (int m = 0; m < 4; ++m) {
                    const int pos = p0 + 128 * ai + 16 * m + poff;
#pragma unroll
                    for (int bj = 0; bj < 2; ++bj) {
                        const unsigned d = (unsigned)(c0 + 128 * bj) * rs + (unsigned)pos;
#pragma unroll
                        for (int e = 0; e < 8; ++e) base[d + (unsigned)e * rs] = f2bf(acc[ai][bj][m][e >> 2][e & 3]);
                    }
                    __builtin_amdgcn_sched_barrier(0);
                }
        } else {
            bf16_t* O; float sc = 1.f; int mode = 0;
            if (pn == 2) { O = (bf16_t*)(ws + WS_NAQ); sc = 0.125f * LOG2E; }
            else if (pn == 3) { O = (bf16_t*)(ws + WS_NAK); }
            else if (pn == 5) { O = (bf16_t*)(ws + WS_SGU); mode = 1; }
            else if (pn == 6) { O = (bf16_t*)(ws + WS_SGV); mode = 1; }
            else if (pn == 7) { O = (bf16_t*)(ws + WS_DFQ); sc = 0.17677669529663687f * LOG2E; mode = lat ? 2 : 0; }
            else { O = (bf16_t*)(ws + WS_DFK); mode = lat ? 2 : 0; }
#pragma unroll
            for (int ai = 0; ai < 2; ++ai)
#pragma unroll
                for (int m = 0; m < 4; ++m) {
                    const int row = r0 + 128 * ai + 16 * m, pos = p0 + 128 * ai + 16 * m;
#pragma unroll
                    for (int bj = 0; bj < 2; ++bj) {
                        float v[8];
#pragma unroll
                        for (int e = 0; e < 8; ++e) v[e] = acc[ai][bj][m][e >> 2][e & 3];
                        if (mode == 1) {
#pragma unroll
                            for (int e = 0; e < 8; ++e) v[e] = gelu_tanh(v[e]);
                        } else if (mode == 2) {
                            const int pa = (fq < 2) ? (pos >> 6) : (pos & 63);
                            const LAS float* tab = rope + pa * 16;
#pragma unroll
                            for (int e = 0; e < 8; ++e) {
                                const float pr = __shfl_xor(v[e], 16), cs = tab[2 * e], sn = tab[2 * e + 1];
                                v[e] = v[e] * cs + ((fq & 1) ? pr * sn : -pr * sn);
                            }
                        }
                        u32x4 w; w.x = pk2(v[0] * sc, v[1] * sc); w.y = pk2(v[2] * sc, v[3] * sc); w.z = pk2(v[4] * sc, v[5] * sc); w.w = pk2(v[6] * sc, v[7] * sc);
                        *(u32x4*)(O + ((unsigned)row * 256u + (unsigned)(c0 + 128 * bj))) = w;
                        __builtin_amdgcn_sched_barrier(0);
                    }
                }
        }
    }
};
struct EpiRes {
    static constexpr bool PERM = false, AFTER_DRAIN = false;
    const float* srcL; const float* srcC; float* dstL; float* dstC; const float* gate;
    DI void operator()(const pg8::f32x4 (&acc)[2][2][4][2], const pg8::Unit& u, int wr, int wc, int fr, int fq) const {
        const int pm = u.pm; const bool lat = pm < 128; const float* g = gate + (lat ? (pm >> 4) : 8) * 6144;
        const int row0 = pm * 256 + wr * 64 + fr, col0 = u.pn * 256 + wc * 32 + 4 * fq;
#pragma unroll
        for (int ai = 0; ai < 2; ++ai)
#pragma unroll
            for (int m = 0; m < 4; ++m) {
                const int row = row0 + 128 * ai + 16 * m;
                const float* s = lat ? srcL : srcC; float* d = lat ? dstL : dstC;
                const unsigned ro = (unsigned)(lat ? row : row - ML) * 1024u;
#pragma unroll
                for (int bj = 0; bj < 2; ++bj)
#pragma unroll
                    for (int n = 0; n < 2; ++n) {
                        const unsigned col = (unsigned)(col0 + 128 * bj + 16 * n);
                        const f32x4 xv = *(const f32x4*)(s + (ro + col)), gv = *(const f32x4*)(g + col);
                        *(f32x4*)(d + (ro + col)) = xv + gv * acc[ai][bj][m][n];
                    }
            }
    }
};
struct SplitOrder {
    int kshift, G, c;
    DI bool next(int i, pg8::Unit& u) const { const int p = i * G + c; if (p >= 128) return false; u.pm = 128 + (p >> 4); u.pn = (p >> 2) & 3; u.ko = (p & 3) << kshift; return true; }
    DI void a_ready(const pg8::Unit&) const {}
    DI void done(const pg8::Unit&) const {}
};
struct EpiPartial {
    static constexpr bool PERM = false, AFTER_DRAIN = false;
    float* PB; int kshift;
    DI void operator()(const pg8::f32x4 (&acc)[2][2][4][2], const pg8::Unit& u, int wr, int wc, int fr, int fq) const {
        float* base = PB + (size_t)(u.ko >> kshift) * MC * 1024;
        const int row0 = (u.pm - 128) * 256 + wr * 64 + fr, col0 = u.pn * 256 + wc * 32 + 4 * fq;
#pragma unroll
        for (int ai = 0; ai < 2; ++ai)
#pragma unroll
            for (int m = 0; m < 4; ++m)
#pragma unroll
                for (int bj = 0; bj < 2; ++bj)
#pragma unroll
                    for (int n = 0; n < 2; ++n)
                        *(f32x4*)(base + ((unsigned)(row0 + 128 * ai + 16 * m) * 1024u + (unsigned)(col0 + 128 * bj + 16 * n))) = acc[ai][bj][m][n];
    }
};
struct EpiFF1 {
    static constexpr bool PERM = true, AFTER_DRAIN = false;
    bf16_t* U;
    DI void operator()(const pg8::f32x4 (&acc)[2][2][4][2], const pg8::Unit& u, int wr, int wc, int fr, int fq) const {
        const int row0 = u.pm * 256 + wr * 64 + fr, col0 = u.pn * 256 + wc * 32 + 8 * fq;
#pragma unroll
        for (int ai = 0; ai < 2; ++ai)
#pragma unroll
            for (int m = 0; m < 4; ++m)
#pragma unroll
                for (int bj = 0; bj < 2; ++bj) {
                    f32x4 a0 = acc[ai][bj][m][0], a1 = acc[ai][bj][m][1];
                    a0 = __builtin_elementwise_max(a0, (f32x4){0.f, 0.f, 0.f, 0.f}); a1 = __builtin_elementwise_max(a1, (f32x4){0.f, 0.f, 0.f, 0.f});
                    a0 = a0 * a0; a1 = a1 * a1;
                    u32x4 w; w.x = pk2(a0[0], a0[1]); w.y = pk2(a0[2], a0[3]); w.z = pk2(a1[0], a1[1]); w.w = pk2(a1[2], a1[3]);
                    *(u32x4*)(U + ((unsigned)(row0 + 128 * ai + 16 * m) * 4096u + (unsigned)(col0 + 128 * bj))) = w;
                }
    }
};
constexpr float C16[16] = {1.f, 0.92387953251f, 0.70710678119f, 0.38268343237f, 0.f, -0.38268343237f, -0.70710678119f, -0.92387953251f,
                           -1.f, -0.92387953251f, -0.70710678119f, -0.38268343237f, 0.f, 0.38268343237f, 0.70710678119f, 0.92387953251f};
constexpr float S16[16] = {0.f, 0.38268343237f, 0.70710678119f, 0.92387953251f, 1.f, 0.92387953251f, 0.70710678119f, 0.38268343237f,
                           0.f, -0.38268343237f, -0.70710678119f, -0.92387953251f, -1.f, -0.92387953251f, -0.70710678119f, -0.38268343237f};
struct EpiFour {
    static constexpr bool PERM = true, AFTER_DRAIN = false;
    bf16_t* Y; int rowbase, rpb; float scale; int kind;
    DI void operator()(const pg8::f32x4 (&acc)[2][2][4][2], const pg8::Unit& u, int wr, int wc, int fr, int fq) const {
        if (kind == 0) {
            const int b = u.pn >> 4, hm = 16 * (u.pn & 15) + 4 * wc + fq;
#pragma unroll
            for (int m = 0; m < 4; ++m) {
                const int k1 = 128 * u.pm + 64 * wr + 16 * m + fr;
                float zr[16], zi[16];
#pragma unroll
                for (int n2 = 0; n2 < 16; ++n2) {
                    const float tc = acc[0][n2 >> 3][m][(n2 >> 2) & 1][n2 & 3], ts = acc[1][n2 >> 3][m][(n2 >> 2) & 1][n2 & 3];
                    const float fr_ = (float)((n2 * k1) & 4095) * (1.f / 4096.f);
                    const float c = __builtin_amdgcn_cosf(fr_), sn = __builtin_amdgcn_sinf(fr_);
                    zr[n2] = tc * c + ts * sn; zi[n2] = tc * sn - ts * c;
                }
                bf16_t* yp = Y + ((unsigned)(b * 4096 + k1) * 1024u + (unsigned)hm);
#pragma unroll
                for (int k2 = 0; k2 < 16; ++k2) {
                    float o = 0.f;
#pragma unroll
                    for (int n2 = 0; n2 < 16; ++n2) {
                        const float cc = C16[(n2 * k2) & 15], sc = S16[(n2 * k2) & 15];
                        if (cc != 0.f) o += zr[n2] * cc;
                        if (sc != 0.f) o -= zi[n2] * sc;
                    }
                    yp[(unsigned)k2 * 256u * 1024u] = f2bf(o * (1.f / 512.f));
                }
                __builtin_amdgcn_sched_barrier(0);
            }
            return;
        }
        const int row0 = rowbase + u.pn * rpb + u.pm * 256 + wr * 64 + fr, col0 = wc * 32 + 8 * fq;
#pragma unroll
        for (int ai = 0; ai < 2; ++ai)
#pragma unroll
            for (int m = 0; m < 4; ++m)
#pragma unroll
                for (int bj = 0; bj < 2; ++bj) {
                    const f32x4 a0 = acc[ai][bj][m][0] * scale, a1 = acc[ai][bj][m][1] * scale;
                    u32x4 w; w.x = pk2(a0[0], a0[1]); w.y = pk2(a0[2], a0[3]); w.z = pk2(a1[0], a1[1]); w.w = pk2(a1[2], a1[3]);
                    *(u32x4*)(Y + ((unsigned)(row0 + 128 * ai + 16 * m) * 1024u + (unsigned)(col0 + 128 * bj))) = w;
                }
    }
};

DI bf16x8 ldg8(const bf16_t* p) { return *(const bf16x8*)p; }
DI bf16x8 ldv(const bf16_t* p) { const s16x4 lo = *(const s16x4*)p, hi = *(const s16x4*)(p + 8); return __builtin_shufflevector(lo, hi, 0, 1, 2, 3, 4, 5, 6, 7); }
DI f32x16 zero16() { f32x16 z; for (int i = 0; i < 16; ++i) z[i] = 0.f; return z; }
DI void softmax_step(f32x16& s, float& m, float& l, f32x16& Oa, f32x16& Ob, bf16x8& pa, bf16x8& pb) {
    float t = s[0];
#pragma unroll
    for (int i = 1; i < 16; ++i) t = fmaxf(t, s[i]);
    t = fmaxf(t, xor32(t));
    const float mn = fmaxf(m, t), al = ex2(m - mn); m = mn;
    float sum = 0.f;
#pragma unroll
    for (int i = 0; i < 16; ++i) { const float p = s[i] > -1e29f ? ex2(s[i] - mn) : 0.f; s[i] = p; sum += p; }
    l = l * al + sum; Oa = Oa * al; Ob = Ob * al;
    u32x4 a, b;
    a.x = pk2(s[0], s[1]); a.y = pk2(s[2], s[3]); a.z = pk2(s[4], s[5]); a.w = pk2(s[6], s[7]);
    b.x = pk2(s[8], s[9]); b.y = pk2(s[10], s[11]); b.z = pk2(s[12], s[13]); b.w = pk2(s[14], s[15]);
    pa = __builtin_bit_cast(bf16x8, a); pb = __builtin_bit_cast(bf16x8, b);
}

DI float exp_sum(const f32x16& sa, const f32x16& sb, f32x16& pa, f32x16& pb) {
    f32x2 s2 = {0.f, 0.f};
#pragma unroll
    for (int i = 0; i < 16; i += 2) {
        pa[i] = ex2(sa[i]); pa[i + 1] = ex2(sa[i + 1]); pb[i] = ex2(sb[i]); pb[i + 1] = ex2(sb[i + 1]);
        s2 += (f32x2){pa[i], pa[i + 1]}; s2 += (f32x2){pb[i], pb[i + 1]};
    }
    return s2.x + s2.y;
}
DI void smax64(f32x16& sa, f32x16& sb, float& m, float& l, f32x16& Oa, f32x16& Ob, const bool first, bf16x8 (&p)[4]) {
    f32x16 pa, pb;
    float sum = exp_sum(sa, sb, pa, pb);
    if (first || __ballot(!(sum <= 65536.f)) != 0ull) {
        float t = fmaxf(sa[0], sb[0]);
#pragma unroll
        for (int i = 1; i < 16; ++i) t = fmaxf(t, fmaxf(sa[i], sb[i]));
        t = fmaxf(t, xor32(t));
        const float delta = first ? t : fmaxf(t, 0.f);
        const float al = first ? 1.f : ex2(-delta);
        m += delta; l *= al; Oa = Oa * al; Ob = Ob * al;
#pragma unroll
        for (int i = 0; i < 16; ++i) { sa[i] -= delta; sb[i] -= delta; }
        sum = exp_sum(sa, sb, pa, pb);
    }
    l += sum;
    u32x4 w;
    w.x = pk2(pa[0], pa[1]); w.y = pk2(pa[2], pa[3]); w.z = pk2(pa[4], pa[5]); w.w = pk2(pa[6], pa[7]); p[0] = __builtin_bit_cast(bf16x8, w);
    w.x = pk2(pa[8], pa[9]); w.y = pk2(pa[10], pa[11]); w.z = pk2(pa[12], pa[13]); w.w = pk2(pa[14], pa[15]); p[1] = __builtin_bit_cast(bf16x8, w);
    w.x = pk2(pb[0], pb[1]); w.y = pk2(pb[2], pb[3]); w.z = pk2(pb[4], pb[5]); w.w = pk2(pb[6], pb[7]); p[2] = __builtin_bit_cast(bf16x8, w);
    w.x = pk2(pb[8], pb[9]); w.y = pk2(pb[10], pb[11]); w.z = pk2(pb[12], pb[13]); w.w = pk2(pb[14], pb[15]); p[3] = __builtin_bit_cast(bf16x8, w);
}
DI bf16x8 ldsv(const LAS unsigned char* p) { const s16x4 lo = *(const LAS s16x4*)p, hi = *(const LAS s16x4*)(p + 16); return __builtin_shufflevector(lo, hi, 0, 1, 2, 3, 4, 5, 6, 7); }

constexpr int DKB = 9216, DBUF = 17920;
DI void diff_item(const Args& A, int l, int b, int h, int qb, LAS unsigned char* lds, const int tid) {
    const int lane = tid & 63, wid = tid >> 6, lh = lane >> 5, ln = lane & 31;
    const bf16_t* Q = (const bf16_t*)(A.ws + WS_DFQ); const bf16_t* K = (const bf16_t*)(A.ws + WS_DFK);
    const bf16_t* VT = (const bf16_t*)(A.ws + WS_DFVT) + (size_t)(b * 256 + h * 64) * KV;
    const int qrow = (qb >= 0 ? b * 4096 + qb * 256 : ML + b * 256) + wid * 32 + ln;
    const bf16_t* qp = Q + (size_t)qrow * 256 + h * 64 + 8 * lh;
    const bf16x8 q1a = ldg8(qp), q1b = ldg8(qp + 16), q2a = ldg8(qp + 32), q2b = ldg8(qp + 48);
    const int lk = tid >> 3, lc = tid & 7;
    const bf16_t* kgL = K + (size_t)(b * 4096 + lk) * 256 + h * 64 + lc * 8;
    const bf16_t* kgC = K + (size_t)(ML + b * 256 + lk) * 256 + h * 64 + lc * 8;
    const bf16_t* vg = VT + (size_t)lk * KV + lc * 8;
    LAS unsigned char* kw = lds + lk * 144 + lc * 16;
    LAS unsigned char* vw = lds + DKB + lk * 136 + lc * 16;
    const LAS unsigned char* kr = lds + ln * 144 + lh * 16;
    const LAS unsigned char* vr = lds + DKB + ln * 136 + lh * 8;
    const int st0 = qb >= 0 ? 0 : 64;
    f32x16 O1a = zero16(), O1b = zero16(), O2a = zero16(), O2b = zero16();
    float m1 = 0.f, l1 = 0.f, m2 = 0.f, l2 = 0.f;
    __syncthreads();
    {
        const bf16x8 kreg = ldg8(st0 < 64 ? kgL + (size_t)st0 * 64 * 256 : kgC + (size_t)(st0 - 64) * 64 * 256);
        const bf16x8 vreg = ldg8(vg + st0 * 64);
        *(LAS bf16x8*)kw = kreg;
        const u32x4 vv = __builtin_bit_cast(u32x4, vreg);
        *(LAS u32x2*)vw = (u32x2){vv.x, vv.y}; *(LAS u32x2*)(vw + 8) = (u32x2){vv.z, vv.w};
    }
    __syncthreads();
    if (__builtin_amdgcn_readfirstlane(tid) >= 256) __builtin_amdgcn_s_setprio(1);
    for (int st = st0; st < 68; ++st) {
        const int cur = (st - st0) & 1; const bool more = st + 1 < 68, first = st == st0;
        bf16x8 kreg, vreg;
        if (more) { const int sn = st + 1; kreg = ldg8(sn < 64 ? kgL + (size_t)sn * 64 * 256 : kgC + (size_t)(sn - 64) * 64 * 256); vreg = ldg8(vg + sn * 64); }
        const LAS unsigned char* kb = kr + cur * DBUF; const LAS unsigned char* vb = vr + cur * DBUF;
        f32x16 ng1, ng2; { const float n1 = -m1, n2 = -m2;
#pragma unroll
          for (int i = 0; i < 16; ++i) { ng1[i] = n1; ng2[i] = n2; } }
        f32x16 s1a = MFMA32(*(const LAS bf16x8*)(kb), q1a, ng1); s1a = MFMA32(*(const LAS bf16x8*)(kb + 32), q1b, s1a);
        f32x16 s1b = MFMA32(*(const LAS bf16x8*)(kb + 32 * 144), q1a, ng1); s1b = MFMA32(*(const LAS bf16x8*)(kb + 32 * 144 + 32), q1b, s1b);
        f32x16 s2a = MFMA32(*(const LAS bf16x8*)(kb + 64), q2a, ng2); s2a = MFMA32(*(const LAS bf16x8*)(kb + 96), q2b, s2a);
        f32x16 s2b = MFMA32(*(const LAS bf16x8*)(kb + 32 * 144 + 64), q2a, ng2); s2b = MFMA32(*(const LAS bf16x8*)(kb + 32 * 144 + 96), q2b, s2b);
        bf16x8 p[4], r[4];
        smax64(s1a, s1b, m1, l1, O1a, O1b, first, p);
#pragma unroll
        for (int j = 0; j < 2; ++j) {
            O1a = MFMA32(ldsv(vb + 64 * j), p[2 * j], O1a); O1a = MFMA32(ldsv(vb + 64 * j + 32), p[2 * j + 1], O1a);
            O1b = MFMA32(ldsv(vb + 32 * 136 + 64 * j), p[2 * j], O1b); O1b = MFMA32(ldsv(vb + 32 * 136 + 64 * j + 32), p[2 * j + 1], O1b);
        }
        smax64(s2a, s2b, m2, l2, O2a, O2b, first, r);
#pragma unroll
        for (int j = 0; j < 2; ++j) {
            O2a = MFMA32(ldsv(vb + 64 * j), r[2 * j], O2a); O2a = MFMA32(ldsv(vb + 64 * j + 32), r[2 * j + 1], O2a);
            O2b = MFMA32(ldsv(vb + 32 * 136 + 64 * j), r[2 * j], O2b); O2b = MFMA32(ldsv(vb + 32 * 136 + 64 * j + 32), r[2 * j + 1], O2b);
        }
        if (more) {
            *(LAS bf16x8*)(kw + (cur ^ 1) * DBUF) = kreg;
            const u32x4 vv = __builtin_bit_cast(u32x4, vreg);
            *(LAS u32x2*)(vw + (cur ^ 1) * DBUF) = (u32x2){vv.x, vv.y}; *(LAS u32x2*)(vw + (cur ^ 1) * DBUF + 8) = (u32x2){vv.z, vv.w};
        }
        __syncthreads();
    }
    __builtin_amdgcn_s_setprio(0);
    l1 += xor32(l1); l2 += xor32(l2);
    const float* lt = (const float*)(A.ws + WS_LAM);
    const float i1 = 1.f / l1, i2 = lt[2 * l] / l2, oml = lt[2 * l + 1];
    float ss = 0.f;
#pragma unroll
    for (int i = 0; i < 16; ++i) { O1a[i] = O1a[i] * i1 - O2a[i] * i2; O1b[i] = O1b[i] * i1 - O2b[i] * i2; ss += O1a[i] * O1a[i] + O1b[i] * O1b[i]; }
    ss += xor32(ss);
    const float rn = rsqrtf(ss * (1.f / 64.f) + 1e-6f) * oml;
    const float* g = A.in[19] + l * 64;
    bf16_t* Y = (bf16_t*)(A.ws + WS_H) + (size_t)qrow * 1024 + 768 + h * 64;
#pragma unroll
    for (int ig = 0; ig < 4; ++ig) {
        const int d = 8 * ig + 4 * lh;
        const f32x4 ga = *(const f32x4*)(g + d), gb = *(const f32x4*)(g + 32 + d);
        u32x2 wa, wb;
        wa.x = pk2(O1a[4 * ig] * rn * ga.x, O1a[4 * ig + 1] * rn * ga.y); wa.y = pk2(O1a[4 * ig + 2] * rn * ga.z, O1a[4 * ig + 3] * rn * ga.w);
        wb.x = pk2(O1b[4 * ig] * rn * gb.x, O1b[4 * ig + 1] * rn * gb.y); wb.y = pk2(O1b[4 * ig + 2] * rn * gb.z, O1b[4 * ig + 3] * rn * gb.w);
        *(u32x2*)(Y + d) = wa; *(u32x2*)(Y + 32 + d) = wb;
    }
}

DI void na_item(const Args& A, int l, int b, int h, int rb, LAS unsigned char* lds, LAS float* rpb_s, const int tid) {
    const int lane = tid & 63, wid = __builtin_amdgcn_readfirstlane(tid >> 6), lh = lane >> 5, ln = lane & 31;
    __syncthreads();
    for (int i = tid; i < 465; i += 512) rpb_s[i] = A.in[10][(l * 4 + h) * 465 + i] * LOG2E;
    const bf16_t* Q = (const bf16_t*)(A.ws + WS_NAQ); const bf16_t* K = (const bf16_t*)(A.ws + WS_NAK);
    const bf16_t* VT = (const bf16_t*)(A.ws + WS_NAVT) + (size_t)(b * 256 + h * 64) * KV;
    const bool lat = rb >= 0;
    const int r = rb * 4 + (wid >> 1), qc = (wid & 1) * 32 + ln;
    const int qrow = lat ? b * 4096 + r * 64 + qc : ML + b * 256 + wid * 32 + ln;
    const bf16_t* qp = Q + (size_t)qrow * 256 + h * 64 + 8 * lh;
    const bf16x8 q0 = ldg8(qp), q1 = ldg8(qp + 16), q2 = ldg8(qp + 32), q3 = ldg8(qp + 48);
    const int rs = min(max(r - 4, 0), 56), cs = min(max(qc - 8, 0), 48);
    const int rmin = lat ? min(max(4 * rb - 4, 0), 56) : 0;
    const int nloc = lat ? min(max(4 * rb - 1, 0), 56) + 8 - rmin : 0;
    const int nst = nloc + 4;
    const int lk = tid >> 3, lc = tid & 7;
    const bf16_t* kgL = K + (size_t)(b * 4096 + rmin * 64 + lk) * 256 + h * 64 + lc * 8;
    const bf16_t* kgC = K + (size_t)(ML + b * 256 + lk) * 256 + h * 64 + lc * 8;
    const bf16_t* vg = VT + (size_t)lk * KV + lc * 8;
    LAS unsigned char* kw = lds + lk * 144 + lc * 16;
    LAS unsigned char* vw = lds + DKB + lk * 136 + lc * 16;
    const LAS unsigned char* kr = lds + ln * 144 + lh * 16;
    const LAS unsigned char* vr = lds + DKB + ln * 136 + lh * 8;
    f32x16 Oa = zero16(), Ob = zero16(); float m = 0.f, ls = 0.f; bool started = false;
    {
        const bf16x8 kreg = ldg8(nloc > 0 ? kgL : kgC);
        const bf16x8 vreg = ldg8(vg + (nloc > 0 ? rmin * 64 : 4096));
        *(LAS bf16x8*)kw = kreg;
        const u32x4 vv = __builtin_bit_cast(u32x4, vreg);
        *(LAS u32x2*)vw = (u32x2){vv.x, vv.y}; *(LAS u32x2*)(vw + 8) = (u32x2){vv.z, vv.w};
    }
    __syncthreads();
    for (int j = 0; j < nst; ++j) {
        const int cur = j & 1; const bool more = j + 1 < nst;
        bf16x8 kreg, vreg;
        if (more) { const int jn = j + 1; kreg = ldg8(jn < nloc ? kgL + (size_t)jn * 64 * 256 : kgC + (size_t)(jn - nloc) * 64 * 256); vreg = ldg8(vg + (jn < nloc ? (rmin + jn) * 64 : 4096 + (jn - nloc) * 64)); }
        const bool loc = j < nloc; const int krow = rmin + j;
        if (!loc || (krow >= rs && krow < rs + 8)) {
            const LAS unsigned char* kb = kr + cur * DBUF; const LAS unsigned char* vb = vr + cur * DBUF;
            f32x16 sa = MFMA32(*(const LAS bf16x8*)(kb), q0, zero16()); sa = MFMA32(*(const LAS bf16x8*)(kb + 32), q1, sa);
            sa = MFMA32(*(const LAS bf16x8*)(kb + 64), q2, sa); sa = MFMA32(*(const LAS bf16x8*)(kb + 96), q3, sa);
            f32x16 sb = MFMA32(*(const LAS bf16x8*)(kb + 32 * 144), q0, zero16()); sb = MFMA32(*(const LAS bf16x8*)(kb + 32 * 144 + 32), q1, sb);
            sb = MFMA32(*(const LAS bf16x8*)(kb + 32 * 144 + 64), q2, sb); sb = MFMA32(*(const LAS bf16x8*)(kb + 32 * 144 + 96), q3, sb);
            if (loc) {
                const int dr = krow - r + 7;
#pragma unroll
                for (int i = 0; i < 16; ++i) {
                    const int kc = (i & 3) + 8 * (i >> 2) + 4 * lh;
                    const bool va = kc >= cs && kc < cs + 16, vb2 = kc + 32 >= cs && kc + 32 < cs + 16;
                    const int da = min(max(kc - qc + 15, 0), 30), db = min(max(kc + 32 - qc + 15, 0), 30);
                    sa[i] = va ? sa[i] + rpb_s[dr * 31 + da] - m : -1e30f;
                    sb[i] = vb2 ? sb[i] + rpb_s[dr * 31 + db] - m : -1e30f;
                }
            } else {
#pragma unroll
                for (int i = 0; i < 16; ++i) { sa[i] -= m; sb[i] -= m; }
            }
            bf16x8 p[4];
            smax64(sa, sb, m, ls, Oa, Ob, !started, p); started = true;
#pragma unroll
            for (int jj = 0; jj < 2; ++jj) {
                Oa = MFMA32(ldsv(vb + 64 * jj), p[2 * jj], Oa); Oa = MFMA32(ldsv(vb + 64 * jj + 32), p[2 * jj + 1], Oa);
                Ob = MFMA32(ldsv(vb + 32 * 136 + 64 * jj), p[2 * jj], Ob); Ob = MFMA32(ldsv(vb + 32 * 136 + 64 * jj + 32), p[2 * jj + 1], Ob);
            }
        }
        if (more) {
            *(LAS bf16x8*)(kw + (cur ^ 1) * DBUF) = kreg;
            const u32x4 vv = __builtin_bit_cast(u32x4, vreg);
            *(LAS u32x2*)(vw + (cur ^ 1) * DBUF) = (u32x2){vv.x, vv.y}; *(LAS u32x2*)(vw + (cur ^ 1) * DBUF + 8) = (u32x2){vv.z, vv.w};
        }
        __syncthreads();
    }
    ls += xor32(ls);
    const float inv = 1.f / ls;
    bf16_t* Y = (bf16_t*)(A.ws + WS_H) + (size_t)qrow * 1024 + 256 + h * 64;
#pragma unroll
    for (int ig = 0; ig < 4; ++ig) {
        const int d = 8 * ig + 4 * lh;
        u32x2 wa, wb;
        wa.x = pk2(Oa[4 * ig] * inv, Oa[4 * ig + 1] * inv); wa.y = pk2(Oa[4 * ig + 2] * inv, Oa[4 * ig + 3] * inv);
        wb.x = pk2(Ob[4 * ig] * inv, Ob[4 * ig + 1] * inv); wb.y = pk2(Ob[4 * ig + 2] * inv, Ob[4 * ig + 3] * inv);
        *(u32x2*)(Y + d) = wa; *(u32x2*)(Y + 32 + d) = wb;
    }
}

DI void smax32(f32x16& sa, float& m, float& l, f32x16& Oa, f32x16& Ob, bool& started, bf16x8 (&p)[2]) {
    f32x16 pa; f32x2 s2 = {0.f, 0.f};
#pragma unroll
    for (int i = 0; i < 16; i += 2) { pa[i] = ex2(sa[i]); pa[i + 1] = ex2(sa[i + 1]); s2 += (f32x2){pa[i], pa[i + 1]}; }
    float sum = s2.x + s2.y;
    if (__ballot(!(sum <= 65536.f) || !started) != 0ull) {
        float t = sa[0];
#pragma unroll
        for (int i = 1; i < 16; ++i) t = fmaxf(t, sa[i]);
        t = fmaxf(t, xor32(t));
        const bool has = t > -1e29f;
        const float delta = started ? fmaxf(t, 0.f) : (has ? t : 0.f);
        const float al = started ? ex2(-delta) : 1.f;
        m += delta; l *= al; Oa = Oa * al; Ob = Ob * al;
        started = started || has;
        s2 = (f32x2){0.f, 0.f};
#pragma unroll
        for (int i = 0; i < 16; i += 2) { pa[i] = ex2(sa[i] - delta); pa[i + 1] = ex2(sa[i + 1] - delta); s2 += (f32x2){pa[i], pa[i + 1]}; }
        sum = s2.x + s2.y;
    }
    l += sum;
    u32x4 w;
    w.x = pk2(pa[0], pa[1]); w.y = pk2(pa[2], pa[3]); w.z = pk2(pa[4], pa[5]); w.w = pk2(pa[6], pa[7]); p[0] = __builtin_bit_cast(bf16x8, w);
    w.x = pk2(pa[8], pa[9]); w.y = pk2(pa[10], pa[11]); w.z = pk2(pa[12], pa[13]); w.w = pk2(pa[14], pa[15]); p[1] = __builtin_bit_cast(bf16x8, w);
}

DI void na_item_lat(const Args& A, int l, int b, int h, int rb, LAS unsigned char* lds, LAS float* rpb_s, const int tid) {
    const int lane = tid & 63, wid = __builtin_amdgcn_readfirstlane(tid >> 6), lh = lane >> 5, ln = lane & 31;
    __syncthreads();
    for (int i = tid; i < 465; i += 512) rpb_s[i] = A.in[10][(l * 4 + h) * 465 + i] * LOG2E;
    const bf16_t* Q = (const bf16_t*)(A.ws + WS_NAQ); const bf16_t* K = (const bf16_t*)(A.ws + WS_NAK);
    const bf16_t* VT = (const bf16_t*)(A.ws + WS_NAVT) + (size_t)(b * 256 + h * 64) * KV;
    const int ra = rb * 4 + 2 * (wid >> 2), jg = wid & 3;
    const int r = ra + (ln >> 4), qc = 16 * jg + (ln & 15);
    const int qrow = b * 4096 + r * 64 + qc;
    const bf16_t* qp = Q + (size_t)qrow * 256 + h * 64 + 8 * lh;
    const bf16x8 q0 = ldg8(qp), q1 = ldg8(qp + 16), q2 = ldg8(qp + 32), q3 = ldg8(qp + 48);
    const int rsl = min(max(r - 4, 0), 56), cs = min(max(qc - 8, 0), 48);
    const int w0 = min(max(ra - 4, 0), 56), w1 = min(max(ra - 3, 0), 56) + 8;
    const int t0 = min(max(16 * jg - 8, 0), 32);
    unsigned cmask = 0u;
#pragma unroll
    for (int i = 0; i < 16; ++i) { const int kc = t0 + (i & 3) + 8 * (i >> 2) + 4 * lh; cmask |= (kc >= cs && kc < cs + 16) ? (1u << i) : 0u; }
    const int cbase = t0 + 4 * lh - qc + 15;
    const int rmin = min(max(4 * rb - 4, 0), 56);
    const int nloc = min(max(4 * rb - 1, 0), 56) + 8 - rmin;
    const int nst = nloc + 4;
    const int lk = tid >> 3, lc = tid & 7;
    const bf16_t* kgL = K + (size_t)(b * 4096 + rmin * 64 + lk) * 256 + h * 64 + lc * 8;
    const bf16_t* kgC = K + (size_t)(ML + b * 256 + lk) * 256 + h * 64 + lc * 8;
    const bf16_t* vg = VT + (size_t)lk * KV + lc * 8;
    LAS unsigned char* kw = lds + lk * 144 + lc * 16;
    LAS unsigned char* vw = lds + DKB + lk * 136 + lc * 16;
    const LAS unsigned char* kr = lds + ln * 144 + lh * 16;
    const LAS unsigned char* vr = lds + DKB + ln * 136 + lh * 8;
    f32x16 Oa = zero16(), Ob = zero16(); float m = 0.f, ls = 0.f; bool started = false;
#define NA_KSRC(jn) ((jn) < nloc ? kgL + (size_t)(jn) * 64 * 256 : kgC + (size_t)((jn) - nloc) * 64 * 256)
#define NA_VSRC(jn) (vg + ((jn) < nloc ? (rmin + (jn)) * 64 : 4096 + ((jn) - nloc) * 64))
    bf16x8 kA, vA, kB, vB;
    {
        const bf16x8 kreg = ldg8(NA_KSRC(0));
        const bf16x8 vreg = ldg8(NA_VSRC(0));
        kA = ldg8(NA_KSRC(1)); vA = ldg8(NA_VSRC(1));
        *(LAS bf16x8*)kw = kreg;
        const u32x4 vv = __builtin_bit_cast(u32x4, vreg);
        *(LAS u32x2*)vw = (u32x2){vv.x, vv.y}; *(LAS u32x2*)(vw + 8) = (u32x2){vv.z, vv.w};
    }
    kB = kA; vB = vA;
    __syncthreads();
    for (int j = 0; j < nst; ++j) {
        const int cur = j & 1; const bool more = j + 1 < nst;
        if (j + 2 < nst) { kB = ldg8(NA_KSRC(j + 2)); vB = ldg8(NA_VSRC(j + 2)); }
        const bool loc = j < nloc; const int krow = rmin + j;
        const LAS unsigned char* kb = kr + cur * DBUF; const LAS unsigned char* vb = vr + cur * DBUF;
        if (loc) {
            if (krow >= w0 && krow < w1) {
                const LAS unsigned char* kt = kb + t0 * 144; const LAS unsigned char* vt = vb + t0 * 2;
                f32x16 sa = MFMA32(*(const LAS bf16x8*)(kt), q0, zero16()); sa = MFMA32(*(const LAS bf16x8*)(kt + 32), q1, sa);
                sa = MFMA32(*(const LAS bf16x8*)(kt + 64), q2, sa); sa = MFMA32(*(const LAS bf16x8*)(kt + 96), q3, sa);
                const bool rv = krow >= rsl && krow < rsl + 8;
                const LAS float* rp = rpb_s + ((krow - r + 7) * 31 + cbase);
#pragma unroll
                for (int i = 0; i < 16; ++i) sa[i] = (rv && ((cmask >> i) & 1u)) ? sa[i] + rp[(i & 3) + 8 * (i >> 2)] - m : -1e30f;
                bf16x8 p[2];
                smax32(sa, m, ls, Oa, Ob, started, p);
                Oa = MFMA32(ldsv(vt), p[0], Oa); Oa = MFMA32(ldsv(vt + 32), p[1], Oa);
                Ob = MFMA32(ldsv(vt + 32 * 136), p[0], Ob); Ob = MFMA32(ldsv(vt + 32 * 136 + 32), p[1], Ob);
            }
        } else {
            f32x16 sa = MFMA32(*(const LAS bf16x8*)(kb), q0, zero16()); sa = MFMA32(*(const LAS bf16x8*)(kb + 32), q1, sa);
            sa = MFMA32(*(const LAS bf16x8*)(kb + 64), q2, sa); sa = MFMA32(*(const LAS bf16x8*)(kb + 96), q3, sa);
            f32x16 sb = MFMA32(*(const LAS bf16x8*)(kb + 32 * 144), q0, zero16()); sb = MFMA32(*(const LAS bf16x8*)(kb + 32 * 144 + 32), q1, sb);
            sb = MFMA32(*(const LAS bf16x8*)(kb + 32 * 144 + 64), q2, sb); sb = MFMA32(*(const LAS bf16x8*)(kb + 32 * 144 + 96), q3, sb);
#pragma unroll
            for (int i = 0; i < 16; ++i) { sa[i] -= m; sb[i] -= m; }
            bf16x8 p[4];
            smax64(sa, sb, m, ls, Oa, Ob, false, p);
#pragma unroll
            for (int jj = 0; jj < 2; ++jj) {
                Oa = MFMA32(ldsv(vb + 64 * jj), p[2 * jj], Oa); Oa = MFMA32(ldsv(vb + 64 * jj + 32), p[2 * jj + 1], Oa);
                Ob = MFMA32(ldsv(vb + 32 * 136 + 64 * jj), p[2 * jj], Ob); Ob = MFMA32(ldsv(vb + 32 * 136 + 64 * jj + 32), p[2 * jj + 1], Ob);
            }
        }
        if (more) {
            *(LAS bf16x8*)(kw + (cur ^ 1) * DBUF) = kA;
            const u32x4 vv = __builtin_bit_cast(u32x4, vA);
            *(LAS u32x2*)(vw + (cur ^ 1) * DBUF) = (u32x2){vv.x, vv.y}; *(LAS u32x2*)(vw + (cur ^ 1) * DBUF + 8) = (u32x2){vv.z, vv.w};
        }
        __syncthreads();
        kA = kB; vA = vB;
    }
#undef NA_KSRC
#undef NA_VSRC
    ls += xor32(ls);
    const float inv = 1.f / ls;
    bf16_t* Y = (bf16_t*)(A.ws + WS_H) + (size_t)qrow * 1024 + 256 + h * 64;
#pragma unroll
    for (int ig = 0; ig < 4; ++ig) {
        const int d = 8 * ig + 4 * lh;
        u32x2 wa, wb;
        wa.x = pk2(Oa[4 * ig] * inv, Oa[4 * ig + 1] * inv); wa.y = pk2(Oa[4 * ig + 2] * inv, Oa[4 * ig + 3] * inv);
        wb.x = pk2(Ob[4 * ig] * inv, Ob[4 * ig + 1] * inv); wb.y = pk2(Ob[4 * ig + 2] * inv, Ob[4 * ig + 3] * inv);
        *(u32x2*)(Y + d) = wa; *(u32x2*)(Y + 32 + d) = wb;
    }
}

DI void sgu_item(const Args& A, int l, int ci, LAS unsigned char* lds, const int tid) {
    const int lane = tid & 63, wid = __builtin_amdgcn_readfirstlane(tid >> 6), lh = lane >> 5, ln = lane & 31;
    const int row0 = ci * 128;
    LAS bf16_t* vT = (LAS bf16_t*)lds;
    const bf16_t* SV = (const bf16_t*)(A.ws + WS_SGV); const bf16_t* SU = (const bf16_t*)(A.ws + WS_SGU);
    const f32x4 lg = *(const f32x4*)(A.in[11] + l * 256 + lane * 4), lb = *(const f32x4*)(A.in[12] + l * 256 + lane * 4);
    const int g = wid >> 1, ph = wid & 1;
    bf16x8 bfr[2][8];
    {
        const bf16_t* Wb = (const bf16_t*)(A.ws + WS_SGW) + (size_t)((l * 4 + g) * 128 + 64 * ph + ln) * 128 + 8 * lh;
#pragma unroll
        for (int pt = 0; pt < 2; ++pt)
#pragma unroll
            for (int ks = 0; ks < 8; ++ks) bfr[pt][ks] = ldg8(Wb + (size_t)pt * 32 * 128 + 16 * ks);
    }
    __syncthreads();
#pragma unroll 1
    for (int i4 = 0; i4 < 4; ++i4) {
        const int q0 = wid * 16 + 4 * i4;
        float x[4][4], mu[4], var[4];
#pragma unroll
        for (int rr = 0; rr < 4; ++rr) {
            const u32x2 raw = *(const u32x2*)(SV + (size_t)(row0 + q0 + rr) * 256 + lane * 4);
            x[rr][0] = bf2f(raw.x & 0xffffu); x[rr][1] = bf2f(raw.x >> 16); x[rr][2] = bf2f(raw.y & 0xffffu); x[rr][3] = bf2f(raw.y >> 16);
            mu[rr] = x[rr][0] + x[rr][1] + x[rr][2] + x[rr][3];
        }
#pragma unroll
        for (int o = 32; o > 0; o >>= 1)
#pragma unroll
            for (int rr = 0; rr < 4; ++rr) mu[rr] += __shfl_xor(mu[rr], o);
#pragma unroll
        for (int rr = 0; rr < 4; ++rr) {
            mu[rr] *= (1.f / 256.f);
#pragma unroll
            for (int j = 0; j < 4; ++j) x[rr][j] -= mu[rr];
            var[rr] = x[rr][0] * x[rr][0] + x[rr][1] * x[rr][1] + x[rr][2] * x[rr][2] + x[rr][3] * x[rr][3];
        }
#pragma unroll
        for (int o = 32; o > 0; o >>= 1)
#pragma unroll
            for (int rr = 0; rr < 4; ++rr) var[rr] += __shfl_xor(var[rr], o);
        float rn[4];
#pragma unroll
        for (int rr = 0; rr < 4; ++rr) rn[rr] = rsqrtf(var[rr] * (1.f / 256.f) + 1e-6f);
#pragma unroll
        for (int j = 0; j < 4; ++j) {
            const float gj = lg[j], bj = lb[j];
            u32x2 w; w.x = pk2(x[0][j] * rn[0] * gj + bj, x[1][j] * rn[1] * gj + bj); w.y = pk2(x[2][j] * rn[2] * gj + bj, x[3][j] * rn[3] * gj + bj);
            *(LAS u32x2*)(vT + (lane * 4 + j) * 136 + q0) = w;
        }
    }
    __syncthreads();
    f32x16 acc[2][2];
#pragma unroll
    for (int ct = 0; ct < 2; ++ct)
#pragma unroll
        for (int pt = 0; pt < 2; ++pt) acc[ct][pt] = zero16();
#pragma unroll
    for (int ks = 0; ks < 8; ++ks) {
        bf16x8 af[2];
#pragma unroll
        for (int ct = 0; ct < 2; ++ct) af[ct] = *(const LAS bf16x8*)(vT + (g * 64 + 32 * ct + ln) * 136 + 16 * ks + 8 * lh);
#pragma unroll
        for (int ct = 0; ct < 2; ++ct)
#pragma unroll
            for (int pt = 0; pt < 2; ++pt) acc[ct][pt] = MFMA32(af[ct], bfr[pt][ks], acc[ct][pt]);
    }
    bf16_t* Y = (bf16_t*)(A.ws + WS_H);
#pragma unroll
    for (int pt = 0; pt < 2; ++pt) {
        const int p = 64 * ph + 32 * pt + ln;
        const float bias = A.in[14][(l * 4 + g) * 128 + p];
#pragma unroll
        for (int ct = 0; ct < 2; ++ct)
#pragma unroll
            for (int ig = 0; ig < 4; ++ig) {
                const int c = g * 64 + 32 * ct + 8 * ig + 4 * lh;
                const u32x2 raw = *(const u32x2*)(SU + (size_t)(row0 + p) * 256 + c);
                const float u0 = bf2f(raw.x & 0xffffu), u1 = bf2f(raw.x >> 16), u2 = bf2f(raw.y & 0xffffu), u3 = bf2f(raw.y >> 16);
                u32x2 o; o.x = pk2(u0 * (acc[ct][pt][4 * ig] + bias), u1 * (acc[ct][pt][4 * ig + 1] + bias));
                o.y = pk2(u2 * (acc[ct][pt][4 * ig + 2] + bias), u3 * (acc[ct][pt][4 * ig + 3] + bias));
                *(u32x2*)(Y + (size_t)(row0 + p) * 1024 + 512 + c) = o;
            }
    }
}

#define XB_TMO      128
#define XB_XCNT(j)  (256  + 64 * (j))
#define XB_XSUB(j)  (1280 + 64 * (j))
#define XB_XGEN(j)  (2304 + 64 * (j))
#define XB_TOP      3328
#define XB_TOPGEN   3392
#define XCD_BAR_WORDS 3456
#define XB_SPIN_CAP (1u << 18)

__device__ __forceinline__ unsigned xb_ld(unsigned* p)              { return __hip_atomic_load(p, __ATOMIC_RELAXED, __HIP_MEMORY_SCOPE_AGENT); }
__device__ __forceinline__ unsigned xb_add(unsigned* p, unsigned v) { return __hip_atomic_fetch_add(p, v, __ATOMIC_RELAXED, __HIP_MEMORY_SCOPE_AGENT); }
__device__ __forceinline__ unsigned xb_xcc_id() { return (unsigned)__builtin_amdgcn_s_getreg((3 << 11) | 20) & 0xFu; }
#define XB_SPIN(cond, bar) do { unsigned _sp = 0; while (cond) { __builtin_amdgcn_s_sleep(1); \
    if ((++_sp & 255u) == 0u) { if (xb_ld(&(bar)[XB_TMO])) break; if (_sp > XB_SPIN_CAP) { atomicAdd(&(bar)[XB_TMO], 1u); break; } } } } while (0)

struct XcdBarrier {
    unsigned* bar; unsigned x;
    volatile LAS unsigned* st;
};

__device__ __forceinline__ XcdBarrier xcd_barrier_post(unsigned* bar, volatile LAS unsigned* st) {
    XcdBarrier b; b.bar = bar; b.x = xb_xcc_id(); b.st = st;
    if (threadIdx.x == 0) (void)xb_add(&bar[XB_XCNT(b.x)], 1u);
    return b;
}
__device__ __forceinline__ void xcd_barrier_complete(unsigned* bar, unsigned x, unsigned& nloc, unsigned& nx) {
    const unsigned G = gridDim.x * gridDim.y * gridDim.z;
    unsigned sum, cnt, mine, sp = 0u;
    for (;;) {
        sum = 0u; cnt = 0u; mine = 0u;
#pragma unroll
        for (unsigned j = 0; j < 16; ++j) { const unsigned c = xb_ld(&bar[XB_XCNT(j)]); sum += c; cnt += (c > 0u) ? 1u : 0u; mine = (j == x) ? c : mine; }
        if (sum == G) break;
        __builtin_amdgcn_s_sleep(1);
        if ((++sp & 255u) == 0u) { if (xb_ld(&bar[XB_TMO])) break; if (sp > XB_SPIN_CAP) { atomicAdd(&bar[XB_TMO], 1u); break; } }
    }
    nloc = mine > 0u ? mine : 1u; nx = cnt > 0u ? cnt : 1u;
}

__device__ __forceinline__ void xcd_barrier(const XcdBarrier& b) {
    asm volatile("s_waitcnt vmcnt(0)" ::: "memory");
    __syncthreads();
    if (threadIdx.x == 0) {
        unsigned* bar = b.bar;
        __builtin_amdgcn_s_waitcnt(0);
        unsigned nloc = b.st[0], nx = b.st[1];
        if (nloc == 0u) { xcd_barrier_complete(bar, b.x, nloc, nx); b.st[0] = nloc; b.st[1] = nx; }
        const unsigned old = xb_add(&bar[XB_XSUB(b.x)], 1u);
        const unsigned gen = old / nloc;
        if (old + 1u == (gen + 1u) * nloc) {
            __builtin_amdgcn_fence(__ATOMIC_RELEASE, "agent");
            asm volatile("s_waitcnt vmcnt(0)" ::: "memory");
            const unsigned og = xb_add(&bar[XB_TOP], 1u);
            const unsigned tg = og / nx;
            if (og + 1u == (tg + 1u) * nx) xb_add(&bar[XB_TOPGEN], 1u);
            else XB_SPIN(xb_ld(&bar[XB_TOPGEN]) == tg, bar);
            __builtin_amdgcn_fence(__ATOMIC_ACQUIRE, "agent");
            xb_add(&bar[XB_XGEN(b.x)], 1u);
            asm volatile("s_waitcnt vmcnt(0)" ::: "memory");
        } else {
            XB_SPIN(xb_ld(&bar[XB_XGEN(b.x)]) == gen, bar);
            __builtin_amdgcn_fence(__ATOMIC_ACQUIRE, "agent");
            asm volatile("s_waitcnt vmcnt(0)" ::: "memory");
        }
    }
    __syncthreads();
}

DI void phase_mix(const Args& A, int l, LAS unsigned char* lds, int rep) {
    const bool last = l == DEPTH - 1;
    const int nF = 256, nD = 512, nN = 512, nS = last ? 256 : 272, nFc = last ? 0 : 8, nDc = last ? 0 : 32, nNc = last ? 0 : 32;
    const int e0 = nF, e1 = e0 + nD, e2 = e1 + nN, e3 = e2 + nS, e4 = e3 + nFc, e5 = e4 + nDc, e6 = e5 + nNc, e7 = e6 + (last ? 0 : 704);
    unsigned* ctr = (unsigned*)(A.ws + WS_CTL) + l * 64 + rep * 16;
    LAS int* s_item = (LAS int*)(lds + MISC_OFF);
    LAS float* rpb_s = (LAS float*)(lds + RPB_OFF);
    bf16_t* Y = (bf16_t*)(A.ws + WS_H);
    for (;;) {
        __syncthreads();
        if (threadIdx.x == 0) *s_item = (int)atomicAdd(ctr, 1u);
        __syncthreads();
        const int it = *s_item;
        if (it >= e7) break;
        int tid = threadIdx.x; asm volatile("" : "+v"(tid));
#if PROBE_KIND >= 0
        { const int kind = (it < e0 || (it >= e3 && it < e4)) ? 0 : ((it < e1 || (it >= e4 && it < e5)) ? 1 : (it < e3 ? 3 : 2)); if (rep && kind != PROBE_KIND) continue; }
#endif
        if (it < e0 || (it >= e3 && it < e4)) {
            const bool c = it >= e3;
            pg8::Gemm g{(const bf16_t*)(A.ws + (c ? WS_CSC : WS_CS)), (const bf16_t*)(A.ws + (c ? WS_PQTC : WS_PQT)), c ? 256 : 512, c ? 2048 : 32768, 512};
            OneUnit S{{c ? 0 : (it & 1), c ? it - e3 : (it >> 1)}}; EpiFour E{Y, ML, 256, 1.f / 128.f, c ? 1 : 0};
            if (EN_F) pg8::gemm_phase<EpiFour, OneUnit, true, true>(lds, g, S, E, tid);
        } else if (it < e1) { const int j = it - e0; if (EN_D) diff_item(A, l, j >> 6, (j >> 4) & 3, j & 15, lds, tid); }
        else if (it < e2) { const int j = it - e1; if (EN_N) na_item_lat(A, l, j >> 6, (j >> 4) & 3, j & 15, lds, rpb_s, tid); }
        else if (it < e3) { if (EN_S) sgu_item(A, l, it - e2, lds, tid); }
        else if (it < e5) { const int j = it - e4; if (EN_D) diff_item(A, l, j >> 2, j & 3, -1, lds, tid); }
        else if (it < e6) { const int j = it - e5; if (EN_N) na_item(A, l, j >> 2, j & 3, -1, lds, rpb_s, tid); }
        else transpose_tile(A, l + 1, it - e6, lds, tid);
    }
}

constexpr int N_PHASES = 2 + 7 * DEPTH;
__global__ void __launch_bounds__(512, 2) mk_fwd(Args A) {
    extern __shared__ __attribute__((aligned(16))) unsigned char lds_raw[];
    LAS unsigned char* lds = (LAS unsigned char*)lds_raw;
    unsigned char* ws = A.ws;
    float* cx = (float*)(ws + WS_CX);
    const float* MOD = (const float*)(ws + WS_MOD);
    volatile LAS unsigned* bst = (volatile LAS unsigned*)(lds + MISC_OFF + 16);
    if (threadIdx.x == 0) { bst[0] = 0u; bst[1] = 0u; }
    __syncthreads();
    const XcdBarrier bar = xcd_barrier_post((unsigned*)(ws + WS_CTL) + 1024, bst);
    for (int ph = A.ph_lo; ph < A.ph_hi; ++ph) {
        if (ph > A.ph_lo) { if (A.ph_lo < 0) cg::this_grid().sync(); else xcd_barrier(bar); }
        int tid = threadIdx.x; asm volatile("" : "+v"(tid));
        if (ph == 0) { if (EN_P) phase_prologue(A, lds, tid);
#if PROBE_P0
            xcd_barrier(bar); tid = threadIdx.x; asm volatile("" : "+v"(tid)); phase_prologue(A, lds, tid, PROBE_P0);
#endif
            continue; }
        if (ph == N_PHASES - 1) {
#if PROBE_SYNC
            for (int q = 0; q < 32; ++q) xcd_barrier(bar);
#endif
            phase_final(A, tid); continue; }
        const int l = (ph - 1) / 7, s = (ph - 1) % 7; const bool last = l == DEPTH - 1;
        const float* xl = l == 0 ? A.in[0] : A.out;
        const int Mrows = last ? ML : MT;
        const float* mod = MOD + (size_t)l * 9 * 6144;
#if PROBE_S >= 0
        for (int rep = 0; rep < ((s == PROBE_S) ? 2 : 1); ++rep) {
        if (rep) { xcd_barrier(bar); tid = threadIdx.x; asm volatile("" : "+v"(tid)); }
#else
        { const int rep = 0;
#endif
        if (s == 0) phase_norm(A, l, 0, MT, xl, cx, l > 0 ? MOD + (size_t)((l - 1) * 9 + 8) * 6144 + 5 * 1024 : nullptr, tid);
        else if (s == 1) {
            LAS float* rope = (LAS float*)(lds + ROPE_OFF);
            { const int i = tid, pos = i >> 3, f = i & 7; const float ang = (float)pos * exp2f(-(float)f * (13.287712379549449f / 8.f));
              float t = ang * 0.15915494309189535f; t -= floorf(t); rope[2 * i] = __builtin_amdgcn_cosf(t); rope[2 * i + 1] = __builtin_amdgcn_sinf(t); }
            __syncthreads();
            pg8::Gemm g{(const bf16_t*)(ws + WS_H), (const bf16_t*)(ws + WS_WIN) + (size_t)l * NIN * 1024, MT, NIN, 1024};
            pg8::StaticOrder S; S.init(MT, NIN, gridDim.x, blockIdx.x); EpiIn E{ws, rope};
            if (EN_I) pg8::gemm_phase<EpiIn, pg8::StaticOrder, true, true>(lds, g, S, E, tid);
        } else if (s == 2) phase_mix(A, l, lds, rep);
        else if (s == 3 || s == 6) {
            const bool o = s == 3;
            const bf16_t* Aop = (const bf16_t*)(ws + (o ? WS_H : WS_U));
            const bf16_t* Bop = o ? (const bf16_t*)(ws + WS_WOUT) + (size_t)l * 1024 * 1024 : (const bf16_t*)(ws + WS_WFF2) + (size_t)l * 1024 * 4096;
            const int Kf = o ? 1024 : 4096;
            if (!last) {
                const int ksh = o ? 9 : 11;
                pg8::Gemm g2{Aop, Bop, MT, 1024, Kf / 4, Kf};
                SplitOrder S2{ksh, (int)gridDim.x, (int)blockIdx.x}; EpiPartial E2{(float*)(ws + WS_PB), ksh};
                pg8::gemm_phase<EpiPartial, SplitOrder, true, true>(lds, g2, S2, E2, tid);
                tid = threadIdx.x; asm volatile("" : "+v"(tid));
            }
            pg8::Gemm g{Aop, Bop, ML, 1024, Kf, Kf};
            pg8::StaticOrder S; S.init(ML, 1024, gridDim.x, blockIdx.x); EpiRes E{o ? xl : A.out, cx, A.out, cx, mod + (o ? 2 : 5) * 1024};
            if (EN_R) pg8::gemm_phase<EpiRes, pg8::StaticOrder, true, true>(lds, g, S, E, tid);
        } else if (s == 4) phase_norm(A, l, 1, Mrows, A.out, cx, mod + 8 * 6144 + 2 * 1024, tid);
        else if (s == 5) {
            pg8::Gemm g{(const bf16_t*)(ws + WS_H), (const bf16_t*)(ws + WS_WFF1) + (size_t)l * 4096 * 1024, Mrows, 4096, 1024};
            pg8::StaticOrder S; S.init(Mrows, 4096, gridDim.x, blockIdx.x); EpiFF1 E{(bf16_t*)(ws + WS_U)};
            if (EN_1) pg8::gemm_phase<EpiFF1, pg8::StaticOrder, true, true>(lds, g, S, E, tid);
        }
        }
    }
}

extern "C" void kernel_launch(void* const* d_in, const int* in_sizes, int n_in, void* d_out, int out_size, void* d_ws, size_t ws_size, hipStream_t stream) {
    static int grid = 0;
    if (grid == 0) {
        if (n_in != 23 || in_sizes[0] != ML * DM || out_size != ML * DM || ws_size < WS_END) {
            fprintf(stderr, "kernel_launch: unexpected shapes: n_in %d in0 %d out %d ws %zu (need %zu)\n", n_in, n_in > 0 ? in_sizes[0] : -1, out_size, ws_size, (size_t)WS_END); grid = -1; return; }
        int dev = 0, cus = 0, per_cu = 0;
        (void)hipGetDevice(&dev); (void)hipDeviceGetAttribute(&cus, hipDeviceAttributeMultiprocessorCount, dev);
        if (hipFuncSetAttribute((const void*)mk_fwd, hipFuncAttributeMaxDynamicSharedMemorySize, LDS_BYTES) != hipSuccess) { fprintf(stderr, "kernel_launch: hipFuncSetAttribute failed\n"); grid = -1; return; }
        if (hipOccupancyMaxActiveBlocksPerMultiprocessor(&per_cu, (const void*)mk_fwd, 512, LDS_BYTES) != hipSuccess || per_cu < 1) { fprintf(stderr, "kernel_launch: occupancy query gave %d\n", per_cu); per_cu = 1; }
        (void)hipGetLastError();
        grid = cus * per_cu;
    }
    if (grid < 0) return;
    (void)hipMemsetAsync((char*)d_ws + WS_CTL, 0, 32768, stream);
    Args a{};
    for (int i = 0; i < 23; ++i) a.in[i] = (const float*)d_in[i];
    a.out = (float*)d_out; a.ws = (unsigned char*)d_ws;
#if ONE_LAUNCH
    a.ph_lo = 0; a.ph_hi = N_PHASES;
    void* args[] = {&a};
    hipError_t e = hipLaunchCooperativeKernel((const void*)mk_fwd, dim3(grid), dim3(512), args, LDS_BYTES, stream);
    if (e != hipSuccess) fprintf(stderr, "kernel_launch: cooperative launch failed: %s (grid %d)\n", hipGetErrorString(e), grid);
#else
    for (int ph = 0; ph < N_PHASES; ++ph) { a.ph_lo = ph; a.ph_hi = ph + 1; hipLaunchKernelGGL(mk_fwd, dim3(grid), dim3(512), LDS_BYTES, stream, a); }
#endif
}
```

```cpp
#include <hip/hip_runtime.h>
#include <hip/hip_cooperative_groups.h>
#include <cstdio>
#include <cstdint>
namespace cg = cooperative_groups;
#ifndef ONE_LAUNCH
#define ONE_LAUNCH 1
#endif
#ifndef EN_F
#define EN_F 1
#endif
#ifndef EN_D
#define EN_D 1
#endif
#ifndef EN_N
#define EN_N 1
#endif
#ifndef EN_S
#define EN_S 1
#endif
#ifndef EN_P
#define EN_P 1
#endif
#ifndef EN_I
#define EN_I 1
#endif
#ifndef EN_R
#define EN_R 1
#endif
#ifndef EN_1
#define EN_1 1
#endif
#ifndef PROBE_S
#define PROBE_S -1
#endif
#ifndef PROBE_KIND
#define PROBE_KIND -1
#endif
#ifndef PROBE_P0
#define PROBE_P0 0
#endif
#ifndef PROBE_SYNC
#define PROBE_SYNC 0
#endif
namespace pg8 {
#define PG8_LAS __attribute__((address_space(3)))
typedef unsigned short bf16_t;
typedef short bf16x8 __attribute__((ext_vector_type(8)));
typedef float f32x4 __attribute__((ext_vector_type(4)));
typedef unsigned u32x4 __attribute__((ext_vector_type(4)));
constexpr int BM = 256, BK = 64, HALF = 128, HTB = HALF * BK * 2  , STAGE_BYTES = 8 * HTB, NXCD = 8, WGM = 8;

__host__ __device__ __forceinline__ int lds_byte(int r, int c) { const int st = (r >> 4) * 2 + (c >> 5), rr = r & 15, cc = c & 31, ob = rr * 64 + cc * 2; return st * 1024 + (ob ^ (((ob >> 9) & 1) << 5)); }
__host__ __device__ __forceinline__ void stage_rc(int b, int& R, int& C) { const int st = b / 1024, sb = b % 1024, swz = sb ^ (((sb >> 9) & 1) << 5); R = (st >> 1) * 16 + swz / 64; C = (st & 1) * 32 + (swz % 64) / 2; }
__host__ __device__ __forceinline__ int perm32(int rho) { const int n = rho >> 4, i = rho & 15; return 8 * (i >> 2) + 4 * n + (i & 3); }

struct Unit { int pm, pn, ko; };
struct Gemm { const bf16_t* A; const bf16_t* Bt; int M, N, K, ld; };

struct StaticOrder {
    int nM, nN, nwg, G, c;
    __host__ __device__ void init(int M, int N, int G_, int c_) { nM = M / BM; nN = N / BM; nwg = nM * nN; G = G_; c = c_; }
    __host__ __device__ bool next(int i, Unit& u) const {
        const long L = (long)i * G + c; if (L >= nwg) return false;
        int wgid = (int)L; { const int q = nwg / NXCD, r = nwg % NXCD, xcd = wgid % NXCD, off = wgid / NXCD; wgid = (xcd < r ? xcd * (q + 1) : r * (q + 1) + (xcd - r) * q) + off; }
        const int nig = WGM * nN, gid = wgid / nig, fm = gid * WGM, gsz = (nM - fm) < WGM ? (nM - fm) : WGM;
        u.pm = fm + ((wgid % nig) % gsz); u.pn = (wgid % nig) / gsz; u.ko = 0; return true;
    }
    __device__ __forceinline__ void a_ready(const Unit&) const {}
    __device__ __forceinline__ void done(const Unit&) const {}
};

template <class Epi, class Sched, bool ALIGN_EPI = false, bool SP2 = false>
__device__ __forceinline__ void gemm_phase(PG8_LAS unsigned char* lds, const Gemm g, const Sched& S, const Epi& E, const int tid) {
    const int wid = __builtin_amdgcn_readfirstlane(tid >> 6), lane = tid & 63, wr = wid >> 2, wc = wid & 3, fr = lane & 15, fq = lane >> 4;
    const int K = g.ld ? g.ld : g.K, nt = g.K / BK;
    unsigned voffA[2], voffB[2];
#pragma unroll
    for (int i = 0; i < 2; ++i) { int R, C; stage_rc(tid * 16 + i * 8192, R, C); const int Rb = Epi::PERM ? ((R & ~31) + perm32(R & 31)) : R;
        voffA[i] = (unsigned)(R * K + C) * 2u; voffB[i] = (unsigned)(Rb * K + C) * 2u; }
    const size_t kstep = (size_t)(BK * 2);
    const size_t hstep = (size_t)HALF * K * 2;
    const size_t tstep = 2 * hstep;
    const unsigned ldsw = (unsigned)wid * 1024u;
    const int aoff = lds_byte(wr * 64 + fr, fq * 8), boff = lds_byte(wc * 32 + fr, fq * 8);
#define PG8_SA(b, h) (((b) * 2 + (h)) * HTB)
#define PG8_SB(b, h) ((4 + (b) * 2 + (h)) * HTB)
#define PG8_STAGE(bufoff, gbase, voff) do { _Pragma("unroll") for (int _i = 0; _i < 2; ++_i) \
        __builtin_amdgcn_global_load_lds((const unsigned*)((const char*)(gbase) + (voff)[_i]), (PG8_LAS unsigned*)(lds + (bufoff) + ldsw + _i * 8192), 16, 0, 0); } while (0)
#define PG8_LDA(dst, b, h) do { _Pragma("unroll") for (int m = 0; m < 4; ++m) _Pragma("unroll") for (int k = 0; k < 2; ++k) dst[m][k] = *(const PG8_LAS bf16x8*)(lds + PG8_SA(b, h) + aoff + m * 2048 + k * 1024); } while (0)
#define PG8_LDB(dst, b, h) do { _Pragma("unroll") for (int n = 0; n < 2; ++n) _Pragma("unroll") for (int k = 0; k < 2; ++k) dst[n][k] = *(const PG8_LAS bf16x8*)(lds + PG8_SB(b, h) + boff + n * 2048 + k * 1024); } while (0)
#define PG8_MMA(ai, bj, At, Bt) do { __builtin_amdgcn_s_setprio(1); _Pragma("unroll") for (int m = 0; m < 4; ++m) _Pragma("unroll") for (int n = 0; n < 2; ++n) _Pragma("unroll") for (int k = 0; k < 2; ++k) \
        acc[ai][bj][m][n] = __builtin_amdgcn_mfma_f32_16x16x32_bf16(Bt[n][k], At[m][k], acc[ai][bj][m][n], 0, 0, 0); __builtin_amdgcn_s_setprio(0); } while (0)
#define PG8_WAIT_V(n) asm volatile("s_waitcnt vmcnt(" #n ")" ::: "memory")
#define PG8_WAIT_L(n) asm volatile("s_waitcnt lgkmcnt(" #n ")" ::: "memory")
#define PG8_BAR __builtin_amdgcn_s_barrier()
#define PG8_SCHED __builtin_amdgcn_sched_barrier(0)
    Unit cur, nxt; int ui = 0;
    if (!S.next(0, cur)) return;
    f32x4 acc[2][2][4][2];
#pragma unroll
    for (int a = 0; a < 2; ++a)
#pragma unroll
        for (int b = 0; b < 2; ++b)
#pragma unroll
            for (int m = 0; m < 4; ++m)
#pragma unroll
                for (int n = 0; n < 2; ++n) acc[a][b][m][n] = (f32x4){0.f, 0.f, 0.f, 0.f};
    bf16x8 At[4][2], B0[2][2], B1[2][2];
    const char* cA = (const char*)g.A + (size_t)cur.pm * tstep + cur.ko; const char* cB = (const char*)g.Bt + (size_t)cur.pn * tstep + cur.ko;
    S.a_ready(cur);
    if constexpr (SP2) {
        PG8_STAGE(PG8_SB(0, 0), cB, voffB); PG8_STAGE(PG8_SB(0, 1), cB + hstep, voffB); PG8_STAGE(PG8_SA(0, 0), cA, voffA); PG8_STAGE(PG8_SA(0, 1), cA + hstep, voffA);
        if (wr == 1) PG8_BAR;
        PG8_WAIT_V(2); PG8_BAR;
        PG8_STAGE(PG8_SB(1, 0), cB + kstep, voffB); PG8_STAGE(PG8_SA(1, 0), cA + kstep, voffA); PG8_STAGE(PG8_SB(1, 1), cB + hstep + kstep, voffB);
        PG8_WAIT_V(6); PG8_BAR;
    } else {
        PG8_STAGE(PG8_SB(0, 0), cB, voffB); PG8_STAGE(PG8_SA(0, 0), cA, voffA); PG8_STAGE(PG8_SB(0, 1), cB + hstep, voffB); PG8_STAGE(PG8_SA(0, 1), cA + hstep, voffA);
        if (wr == 1) PG8_BAR;
        PG8_WAIT_V(4); PG8_BAR;
        PG8_STAGE(PG8_SB(1, 0), cB + kstep, voffB); PG8_STAGE(PG8_SA(1, 0), cA + kstep, voffA); PG8_STAGE(PG8_SB(1, 1), cB + hstep + kstep, voffB);
        PG8_WAIT_V(6); PG8_BAR;
    }
    for (;;) {
        const bool has_next = S.next(ui + 1, nxt);
        const char* nA = has_next ? (const char*)g.A + (size_t)nxt.pm * tstep + nxt.ko : cA; const char* nB = has_next ? (const char*)g.Bt + (size_t)nxt.pn * tstep + nxt.ko : cB;
        for (int t = 0; t < nt; t += 2) {
            const bool last = (t == nt - 2);
            const char* a1 = cA + (size_t)(t + 1) * kstep;
            const char* a2 = last ? nA : cA + (size_t)(t + 2) * kstep; const char* b2 = last ? nB : cB + (size_t)(t + 2) * kstep;
            const char* a3 = a2 + kstep; const char* b3 = b2 + kstep;
            if (last && has_next) S.a_ready(nxt);
            if constexpr (SP2) {
            PG8_LDB(B0, 0, 0); PG8_LDB(B1, 0, 1); PG8_SCHED; PG8_LDA(At, 0, 0); PG8_STAGE(PG8_SA(1, 1), a1 + hstep, voffA);
            PG8_WAIT_V(8); PG8_WAIT_L(0); PG8_BAR; PG8_MMA(0, 0, At, B0); PG8_MMA(0, 1, At, B1); PG8_BAR; PG8_SCHED;
            PG8_LDA(At, 0, 1); PG8_STAGE(PG8_SB(0, 0), b2, voffB); PG8_STAGE(PG8_SB(0, 1), b2 + hstep, voffB); PG8_STAGE(PG8_SA(0, 0), a2, voffA);
            PG8_WAIT_V(8); PG8_WAIT_L(0); PG8_BAR; PG8_MMA(1, 0, At, B0); PG8_MMA(1, 1, At, B1); PG8_BAR; PG8_SCHED;
            PG8_LDB(B0, 1, 0); PG8_LDB(B1, 1, 1); PG8_SCHED; PG8_LDA(At, 1, 0); PG8_STAGE(PG8_SA(0, 1), a2 + hstep, voffA);
            PG8_WAIT_V(8); PG8_WAIT_L(0); PG8_BAR; PG8_MMA(0, 0, At, B0); PG8_MMA(0, 1, At, B1); PG8_BAR; PG8_SCHED;
            PG8_LDA(At, 1, 1); PG8_STAGE(PG8_SB(1, 0), b3, voffB); PG8_STAGE(PG8_SB(1, 1), b3 + hstep, voffB); PG8_STAGE(PG8_SA(1, 0), a3, voffA);
            PG8_WAIT_V(8); PG8_WAIT_L(0); PG8_BAR; PG8_MMA(1, 0, At, B0); PG8_MMA(1, 1, At, B1); PG8_BAR; PG8_SCHED;
            } else {
            PG8_LDB(B0, 0, 0); PG8_SCHED; PG8_LDA(At, 0, 0); PG8_STAGE(PG8_SA(1, 1), a1 + hstep, voffA);
            PG8_WAIT_L(8); PG8_BAR; PG8_WAIT_L(0); PG8_MMA(0, 0, At, B0); PG8_BAR; PG8_SCHED;
            PG8_LDB(B1, 0, 1); PG8_STAGE(PG8_SB(0, 0), b2, voffB);
            PG8_BAR; PG8_WAIT_L(0); PG8_MMA(0, 1, At, B1); PG8_BAR;
            PG8_LDA(At, 0, 1); PG8_STAGE(PG8_SA(0, 0), a2, voffA);
            PG8_BAR; PG8_WAIT_L(0); PG8_MMA(1, 0, At, B0); PG8_BAR; PG8_SCHED;
            PG8_STAGE(PG8_SB(0, 1), b2 + hstep, voffB);
            PG8_WAIT_V(6); PG8_BAR; PG8_MMA(1, 1, At, B1); PG8_BAR;
            PG8_LDB(B0, 1, 0); PG8_SCHED; PG8_LDA(At, 1, 0); PG8_STAGE(PG8_SA(0, 1), a2 + hstep, voffA);
            PG8_WAIT_L(8); PG8_BAR; PG8_WAIT_L(0); PG8_MMA(0, 0, At, B0); PG8_BAR; PG8_SCHED;
            PG8_LDB(B1, 1, 1); PG8_STAGE(PG8_SB(1, 0), b3, voffB);
            PG8_BAR; PG8_WAIT_L(0); PG8_MMA(0, 1, At, B1); PG8_BAR;
            PG8_LDA(At, 1, 1); PG8_STAGE(PG8_SA(1, 0), a3, voffA);
            PG8_BAR; PG8_WAIT_L(0); PG8_MMA(1, 0, At, B0); PG8_BAR; PG8_SCHED;
            PG8_STAGE(PG8_SB(1, 1), b3 + hstep, voffB);
            PG8_WAIT_V(6); PG8_BAR; PG8_MMA(1, 1, At, B1); PG8_BAR;
            }
        }
        if constexpr (ALIGN_EPI) { if (wr == 0) PG8_BAR; }
        if constexpr (!Epi::AFTER_DRAIN) { E(acc, cur, wr, wc, fr, fq); S.done(cur); }
        if (!has_next) break;
#pragma unroll
        for (int a = 0; a < 2; ++a)
#pragma unroll
            for (int b = 0; b < 2; ++b)
#pragma unroll
                for (int m = 0; m < 4; ++m)
#pragma unroll
                    for (int n = 0; n < 2; ++n) acc[a][b][m][n] = (f32x4){0.f, 0.f, 0.f, 0.f};
        cur = nxt; cA = nA; cB = nB; ++ui;
        if constexpr (ALIGN_EPI) { if (wr == 1) PG8_BAR; }
    }
    PG8_WAIT_V(0);
    if constexpr (!ALIGN_EPI) { if (wr == 0) PG8_BAR; }
    PG8_BAR;
    if constexpr (Epi::AFTER_DRAIN) { E.fused(acc, cur, wr, wc, fr, fq, lds, wid, lane); S.done(cur); }
#undef PG8_SA
#undef PG8_SB
#undef PG8_STAGE
#undef PG8_LDA
#undef PG8_LDB
#undef PG8_MMA
#undef PG8_WAIT_V
#undef PG8_WAIT_L
#undef PG8_BAR
#undef PG8_SCHED
}
}
#define DI __device__ __forceinline__
#define LAS __attribute__((address_space(3)))
typedef unsigned short bf16_t;
typedef short bf16x8 __attribute__((ext_vector_type(8)));
typedef short s16x4 __attribute__((ext_vector_type(4)));
typedef float f32x4 __attribute__((ext_vector_type(4)));
typedef float f32x2 __attribute__((ext_vector_type(2)));
typedef float f32x16 __attribute__((ext_vector_type(16)));
typedef unsigned u32x4 __attribute__((ext_vector_type(4)));
typedef unsigned u32x2 __attribute__((ext_vector_type(2)));
typedef __bf16 bf2_t __attribute__((ext_vector_type(2)));
DI unsigned pk2(float lo, float hi) { f32x2 v = {lo, hi}; return __builtin_bit_cast(unsigned, __builtin_convertvector(v, bf2_t)); }
DI bf16_t f2bf(float x) { return (bf16_t)(pk2(x, 0.f) & 0xffffu); }
DI float bf2f(unsigned v) { return __builtin_bit_cast(float, v << 16); }
#define MFMA32(a, b, c) __builtin_amdgcn_mfma_f32_32x32x16_bf16((a), (b), (c), 0, 0, 0)
DI float ex2(float x) { return __builtin_amdgcn_exp2f(x); }
DI float xor32(float v) { return __shfl_xor(v, 32); }

constexpr int DM = 1024, NB = 8, SEQ = 4096, DEPTH = 4, CTX = 256, DFF = 4096;
constexpr int ML = NB * SEQ, MC = NB * CTX, MT = ML + MC, NIN = 2560, KV = SEQ + CTX;
constexpr float LOG2E = 1.4426950408889634f;
constexpr size_t MiB = 1u << 20;
constexpr size_t WS_CTL = 0, WS_LAM = 32768, WS_MOD = 1 * MiB, WS_CSC = 2 * MiB, WS_WIN = 4 * MiB, WS_WOUT = 24 * MiB, WS_WFF1 = 32 * MiB,
                 WS_WFF2 = 64 * MiB, WS_CS = 96 * MiB, WS_H = 160 * MiB, WS_CX = 228 * MiB, WS_U = 236 * MiB;
constexpr size_t WS_PQT = WS_U, WS_PQTC = WS_U + 32 * MiB, WS_NAQ = WS_U + 34 * MiB, WS_NAK = WS_U + 51 * MiB, WS_SGU = WS_U + 68 * MiB,
                 WS_SGV = WS_U + 85 * MiB, WS_DFQ = WS_U + 102 * MiB, WS_DFK = WS_U + 119 * MiB, WS_NAVT = WS_U + 136 * MiB, WS_DFVT = WS_U + 153 * MiB;
constexpr size_t WS_END = WS_U + 272 * MiB;
constexpr size_t WS_SGW = 2 * MiB + 256 * 1024;
constexpr size_t WS_PB = WS_CS + 1 * MiB;
constexpr int LDS_BYTES = 147456, MISC_OFF = 131072, ROPE_OFF = MISC_OFF + 1024, RPB_OFF = MISC_OFF + 5120;

struct Args { const float* in[23]; float* out; unsigned char* ws; int ph_lo, ph_hi; };

DI void transpose_tile(const Args& A, int l, int r, LAS unsigned char* lds, const int tid) {
    const int lane = tid & 63, wid = __builtin_amdgcn_readfirstlane(tid >> 6);
    unsigned char* ws = A.ws;
    LAS float* big = (LAS float*)(lds + 53248);
    const float* src; bf16_t* dst; int K, N, kt, nt;
    if (r < 128) { K = 1024; N = 2304; kt = r >> 3; nt = r & 7; src = A.in[8] + (size_t)l * 1024 * 2304 + 256; dst = (bf16_t*)(ws + WS_WIN) + (size_t)l * NIN * 1024 + 512 * 1024; }
    else if (r < 192) { r -= 128; K = 1024; N = 1024; kt = r >> 2; nt = r & 3; src = A.in[9] + (size_t)l * 1024 * 1024; dst = (bf16_t*)(ws + WS_WOUT) + (size_t)l * 1024 * 1024; }
    else if (r < 448) { r -= 192; K = 1024; N = 4096; kt = r >> 4; nt = r & 15; src = A.in[20] + (size_t)l * 1024 * 4096; dst = (bf16_t*)(ws + WS_WFF1) + (size_t)l * 4096 * 1024; }
    else { r -= 448; K = 4096; N = 1024; kt = r >> 2; nt = r & 3; src = A.in[21] + (size_t)l * 4096 * 1024; dst = (bf16_t*)(ws + WS_WFF2) + (size_t)l * 1024 * 4096; }
    float v[32];
    const float* sp = src + (size_t)(kt * 64 + (tid >> 6)) * N + nt * 256 + lane;
#pragma unroll
    for (int i = 0; i < 8; ++i)
#pragma unroll
        for (int j = 0; j < 4; ++j) v[i * 4 + j] = sp[(size_t)(8 * i) * N + 64 * j];
    __syncthreads();
#pragma unroll
    for (int i = 0; i < 8; ++i)
#pragma unroll
        for (int j = 0; j < 4; ++j) big[(wid + 8 * i) * 257 + 64 * j + lane] = v[i * 4 + j];
    __syncthreads();
#pragma unroll 4
    for (int i = 0; i < 32; ++i) { const int nn = wid + 8 * i; dst[(size_t)(nt * 256 + nn) * K + kt * 64 + lane] = f2bf(big[lane * 257 + nn]); }
}

DI void phase_prologue(const Args& A, LAS unsigned char* lds, const int tid, const int parts = 15) {
    const int lane = tid & 63, wid = __builtin_amdgcn_readfirstlane(tid >> 6);
    unsigned char* ws = A.ws;
    LAS float* silu_t = (LAS float*)lds;
    LAS float* cos_t = (LAS float*)(lds + 36864);
    LAS float* tile = (LAS float*)(lds + 53248);
    LAS float* red = (LAS float*)(lds + 69888);
    for (int i = tid; i < 9 * 1024; i += 512) { const int r = i >> 10, k = i & 1023; const float v = r < 8 ? A.in[1][r * 1024 + k] : A.in[3][k]; silu_t[i] = v / (1.f + expf(-v)); }
    for (int i = tid; i < 4096; i += 512) cos_t[i] = cospif((float)i * (1.f / 2048.f));
    LAS float* c64 = (LAS float*)(lds + 122880);
    if (tid < 64) { c64[tid] = cospif((float)tid * (1.f / 32.f)); c64[64 + tid] = sinpif((float)tid * (1.f / 32.f)); }
    if (blockIdx.x == 0 && tid < DEPTH) {
        const int l = tid; float s1 = 0.f, s2 = 0.f;
        for (int i = 0; i < 32; ++i) { s1 += A.in[15][l * 32 + i] * A.in[16][l * 32 + i]; s2 += A.in[17][l * 32 + i] * A.in[18][l * 32 + i]; }
        const float lam_init = 0.8f - 0.6f * expf(-0.3f * (float)l);
        float* lt = (float*)(ws + WS_LAM); lt[2 * l] = expf(s1) - expf(s2) + lam_init; lt[2 * l + 1] = 1.f - lam_init;
    }
    __syncthreads();
    {
        const float* src = A.in[13]; bf16_t* dst = (bf16_t*)(ws + WS_SGW);
        for (int i = blockIdx.x * 512 + tid; i < DEPTH * 4 * 128 * 128 / 2; i += gridDim.x * 512) ((unsigned*)dst)[i] = pk2(src[2 * i], src[2 * i + 1]);
    }
    {
        const f32x4* src = (const f32x4*)A.in[2]; f32x4* dst = (f32x4*)(ws + WS_CX);
        for (int i = blockIdx.x * 512 + tid; i < MC * DM / 4; i += gridDim.x * 512) dst[i] = src[i];
    }
    bf16_t* CS = (bf16_t*)(ws + WS_CS);
    if (parts & 1)
    for (int rr = blockIdx.x; rr < 512; rr += gridDim.x) {
        const int pm = rr >> 8, row = rr & 255, cs = row >> 7, k1 = 128 * pm + (row & 127), pq = tid >> 8, n1 = tid & 255;
        const int t = ((n1 * k1) & 255) * 16;
        const float cv = cos_t[t], sv = cos_t[(t + 3072) & 4095];
        CS[(size_t)rr * 512 + tid] = f2bf(cs == 0 ? (pq == 0 ? cv : sv) : (pq == 0 ? -sv : cv));
    }
    bf16_t* CSc = (bf16_t*)(ws + WS_CSC);
    for (int k = blockIdx.x; k < 256; k += gridDim.x) { const int j = tid, jj = j & 255; int t = ((k * jj) & 255) * 16; if (j >= 256) t = (t + 3072) & 4095; CSc[k * 512 + j] = f2bf(cos_t[t]); }
    if (parts & 2)
    for (int it = blockIdx.x; it < 256; it += gridDim.x) {
        const int l = it >> 6, h = (it >> 4) & 3, kb = it & 15;
        const float* src = A.in[8] + (size_t)l * 1024 * 2304 + (size_t)(kb * 64) * 2304 + h * 64;
        __syncthreads();
#pragma unroll
        for (int i = 0; i < 8; ++i) { const int kk = wid + 8 * i; tile[kk * 65 + lane] = src[(size_t)kk * 2304 + lane]; }
        __syncthreads();
        bf16_t* dst = (bf16_t*)(ws + WS_WIN) + (size_t)l * NIN * 1024;
        const int m = lane;
#pragma unroll 1
        for (int i = 0; i < 8; ++i) {
            const int kk = wid + 8 * i; float P = 0.f, Q = 0.f;
#pragma unroll 4
            for (int c = 0; c < 64; ++c) { const float w = tile[kk * 65 + c]; const int t = (c * m) & 63; P += w * c64[t]; Q += w * c64[64 + t]; }
            dst[(size_t)(h * 64 + m) * 1024 + kb * 64 + kk] = f2bf(P); dst[(size_t)(256 + h * 64 + m) * 1024 + kb * 64 + kk] = f2bf(-Q);
        }
    }
    if (parts & 4)
    for (int it = blockIdx.x; it < 704; it += gridDim.x) transpose_tile(A, 0, it, lds, tid);
    float* MOD = (float*)(ws + WS_MOD);
    if (parts & 8)
    for (int it = blockIdx.x; it < 4 * 192; it += gridDim.x) {
        const int l = it / 192, nb = it % 192, cl = lane & 31, kp = lane >> 5;
        const float* w = A.in[4] + (size_t)l * 1024 * 6144 + nb * 32 + cl;
        float acc[9];
#pragma unroll
        for (int r = 0; r < 9; ++r) acc[r] = 0.f;
#pragma unroll 16
        for (int k = wid * 128 + kp; k < wid * 128 + 128; k += 2) {
            const float wv = w[(size_t)k * 6144];
#pragma unroll
            for (int r = 0; r < 9; ++r) acc[r] += silu_t[r * 1024 + k] * wv;
        }
        __syncthreads();
#pragma unroll
        for (int r = 0; r < 9; ++r) red[(wid * 9 + r) * 64 + lane] = acc[r];
        __syncthreads();
        for (int i = tid; i < 9 * 32; i += 512) {
            const int r = i >> 5, nn = i & 31; float sm = 0.f;
            for (int w8 = 0; w8 < 8; ++w8) sm += red[(w8 * 9 + r) * 64 + nn] + red[(w8 * 9 + r) * 64 + 32 + nn];
            MOD[(size_t)(l * 9 + r) * 6144 + nb * 32 + nn] = sm + A.in[5][l * 6144 + nb * 32 + nn];
        }
    }
}

DI float wave_sum(float v) {
#pragma unroll
    for (int o = 32; o > 0; o >>= 1) v += __shfl_xor(v, o);
    return v;
}
DI void phase_norm(const Args& A, int l, int which, int nrows, const float* srcL, float* srcC, const float* pgate, const int tid) {
    const int lane = tid & 63, wid = tid >> 6;
    const float* g = A.in[which ? 7 : 6] + l * 1024;
    const float* mod = (const float*)(A.ws + WS_MOD) + (size_t)l * 9 * 6144;
    bf16_t* H = (bf16_t*)(A.ws + WS_H);
    const int stride = gridDim.x * 8;
    constexpr int NR = 4;
    for (int row0 = blockIdx.x * 8 + wid; row0 < nrows; row0 += NR * stride) {
        f32x4 v[NR][4]; float ss[NR];
#pragma unroll
        for (int u = 0; u < NR; ++u) {
            const int row = min(row0 + u * stride, nrows - 1);
            const float* src = row < ML ? srcL + (size_t)row * 1024 : srcC + (size_t)(row - ML) * 1024;
            ss[u] = 0.f;
#pragma unroll
            for (int i = 0; i < 4; ++i) v[u][i] = __builtin_nontemporal_load((const f32x4*)(src + i * 256 + lane * 4));
            if (pgate != nullptr && row >= ML) {
                const float* pb = (const float*)(A.ws + WS_PB) + (size_t)(row - ML) * 1024;
#pragma unroll
                for (int i = 0; i < 4; ++i) {
                    const int k = i * 256 + lane * 4;
                    const f32x4 p = *(const f32x4*)(pb + k) + *(const f32x4*)(pb + (size_t)MC * 1024 + k) + *(const f32x4*)(pb + (size_t)2 * MC * 1024 + k) + *(const f32x4*)(pb + (size_t)3 * MC * 1024 + k);
                    v[u][i] = v[u][i] + *(const f32x4*)(pgate + k) * p;
                    if (row0 + u * stride < nrows) *(f32x4*)(srcC + (size_t)(row - ML) * 1024 + k) = v[u][i];
                }
            }
#pragma unroll
            for (int i = 0; i < 4; ++i) ss[u] += v[u][i].x * v[u][i].x + v[u][i].y * v[u][i].y + v[u][i].z * v[u][i].z + v[u][i].w * v[u][i].w;
        }
#pragma unroll
        for (int u = 0; u < NR; ++u) {
            const int row = row0 + u * stride;
            if (row < nrows) {
                const int bidx = row < ML ? (row >> 12) : 8;
                const float* sh = mod + bidx * 6144 + (which ? 3 : 0) * 1024; const float* sc = sh + 1024;
                const float r = rsqrtf(wave_sum(ss[u]) * (1.f / 1024.f) + 1e-6f);
#pragma unroll
                for (int i = 0; i < 4; ++i) {
                    const int k = i * 256 + lane * 4;
                    const f32x4 gv = *(const f32x4*)(g + k), sv = *(const f32x4*)(sc + k), hv = *(const f32x4*)(sh + k);
                    const f32x4 y = v[u][i] * r * gv * (1.f + sv) + hv;
                    u32x2 o; o.x = pk2(y.x, y.y); o.y = pk2(y.z, y.w);
                    *(u32x2*)(H + (size_t)row * 1024 + k) = o;
                }
            }
        }
    }
}
DI void phase_final(const Args& A, const int tid) {
    const int lane = tid & 63, wid = tid >> 6;
    const float* g = A.in[22];
    for (int row = blockIdx.x * 8 + wid; row < ML; row += gridDim.x * 8) {
        float* p = A.out + (size_t)row * 1024;
        f32x4 v[4]; float ss = 0.f;
#pragma unroll
        for (int i = 0; i < 4; ++i) { v[i] = *(const f32x4*)(p + i * 256 + lane * 4); ss += v[i].x * v[i].x + v[i].y * v[i].y + v[i].z * v[i].z + v[i].w * v[i].w; }
        ss = wave_sum(ss);
        const float r = rsqrtf(ss * (1.f / 1024.f) + 1e-6f);
#pragma unroll
        for (int i = 0; i < 4; ++i) { const int k = i * 256 + lane * 4; *(f32x4*)(p + k) = v[i] * r * *(const f32x4*)(g + k); }
    }
}
struct OneUnit {
    pg8::Unit u;
    DI bool next(int i, pg8::Unit& o) const { if (i) return false; o = u; return true; }
    DI void a_ready(const pg8::Unit&) const {}
    DI void done(const pg8::Unit&) const {}
};
DI float gelu_tanh(float x) { const float y = 0.7978845608028654f * (x + 0.044715f * x * x * x); return x * __builtin_amdgcn_rcpf(1.f + ex2(-2.f * LOG2E * y)); }

struct EpiIn {
    static constexpr bool PERM = true, AFTER_DRAIN = false;
    unsigned char* ws; const LAS float* rope;
    DI void operator()(const pg8::f32x4 (&acc)[2][2][4][2], const pg8::Unit& u, int wr, int wc, int fr, int fq) const {
        const int pm = u.pm, pn = u.pn; const bool lat = pm < 128; const int b = lat ? (pm >> 4) : (pm - 128);
        const int r0 = pm * 256 + wr * 64 + fr, c0 = wc * 32 + 8 * fq;
        const int p0 = lat ? (r0 & 4095) : (r0 - ML - b * 256);
        if (pn <= 1 || pn == 4 || pn == 9) {
            bf16_t* base; unsigned rs; int poff;
            if (pn <= 1 && lat) {
                bf16_t* zt = (bf16_t*)(ws + WS_PQT);
                const int n2 = fr, n1b = (pm & 15) * 16 + wr * 4;
#pragma unroll
                for (int ai = 0; ai < 2; ++ai)
#pragma unroll
                    for (int bj = 0; bj < 2; ++bj) {
                        const int hmhi = 2 * wc + 8 * bj + (fq >> 1);
#pragma unroll
                        for (int e = 0; e < 8; ++e) {
                            const int hmlo = 8 * (fq & 1) + e;
                            const int c = 128 * (n2 >> 3) + 4 * ((n2 >> 2) & 1) + (n2 & 3) + 32 * (hmlo >> 2) + 8 * (hmlo & 3);
                            u32x2 w;
                            w.x = pk2(acc[ai][bj][0][e >> 2][e & 3], acc[ai][bj][1][e >> 2][e & 3]); w.y = pk2(acc[ai][bj][2][e >> 2][e & 3], acc[ai][bj][3][e >> 2][e & 3]);
                            *(u32x2*)(zt + ((unsigned)((b * 16 + hmhi) * 256 + c) * 512u + (unsigned)(pn * 256 + n1b + 8 * ai))) = w;
                        }
                        __builtin_amdgcn_sched_barrier(0);
                    }
                return;
            }
            if (pn <= 1) { base = (bf16_t*)(ws + WS_PQTC) + (size_t)b * 256 * 512; rs = 512; poff = 256 * pn; }
            else { base = (bf16_t*)(ws + (pn == 4 ? WS_NAVT : WS_DFVT)) + (size_t)b * 256 * KV; rs = KV; poff = lat ? 0 : 4096; }
#pragma unroll
            for (int ai = 0; ai < 2; ++ai)
#pragma unroll
                for (int m = 0; m < 4; ++m) {
                    const int pos = p0 + 128 * ai + 16 * m + poff;
#pragma unroll
                    for (int bj = 0; bj < 2; ++bj) {
                        const unsigned d = (unsigned)(c0 + 128 * bj) * rs + (unsigned)pos;
#pragma unroll
                        for (int e = 0; e < 8; ++e) base[d + (unsigned)e * rs] = f2bf(acc[ai][bj][m][e >> 2][e & 3]);
                    }
                    __builtin_amdgcn_sched_barrier(0);
                }
        } else {
            bf16_t* O; float sc = 1.f; int mode = 0;
            if (pn == 2) { O = (bf16_t*)(ws + WS_NAQ); sc = 0.125f * LOG2E; }
            else if (pn == 3) { O = (bf16_t*)(ws + WS_NAK); }
            else if (pn == 5) { O = (bf16_t*)(ws + WS_SGU); mode = 1; }
            else if (pn == 6) { O = (bf16_t*)(ws + WS_SGV); mode = 1; }
            else if (pn == 7) { O = (bf16_t*)(ws + WS_DFQ); sc = 0.17677669529663687f * LOG2E; mode = lat ? 2 : 0; }
            else { O = (bf16_t*)(ws + WS_DFK); mode = lat ? 2 : 0; }
#pragma unroll
            for (int ai = 0; ai < 2; ++ai)
#pragma unroll
                for (int m = 0; m < 4; ++m) {
                    const int row = r0 + 128 * ai + 16 * m, pos = p0 + 128 * ai + 16 * m;
#pragma unroll
                    for (int bj = 0; bj < 2; ++bj) {
                        float v[8];
#pragma unroll
                        for (int e = 0; e < 8; ++e) v[e] = acc[ai][bj][m][e >> 2][e & 3];
                        if (mode == 1) {
#pragma unroll
                            for (int e = 0; e < 8; ++e) v[e] = gelu_tanh(v[e]);
                        } else if (mode == 2) {
                            const int pa = (fq < 2) ? (pos >> 6) : (pos & 63);
                            const LAS float* tab = rope + pa * 16;
#pragma unroll
                            for (int e = 0; e < 8; ++e) {
                                const float pr = __shfl_xor(v[e], 16), cs = tab[2 * e], sn = tab[2 * e + 1];
                                v[e] = v[e] * cs + ((fq & 1) ? pr * sn : -pr * sn);
                            }
                        }
                        u32x4 w; w.x = pk2(v[0] * sc, v[1] * sc); w.y = pk2(v[2] * sc, v[3] * sc); w.z = pk2(v[4] * sc, v[5] * sc); w.w = pk2(v[6] * sc, v[7] * sc);
                        *(u32x4*)(O + ((unsigned)row * 256u + (unsigned)(c0 + 128 * bj))) = w;
                        __builtin_amdgcn_sched_barrier(0);
                    }
                }
        }
    }
};
struct EpiRes {
    static constexpr bool PERM = false, AFTER_DRAIN = false;
    const float* srcL; const float* srcC; float* dstL; float* dstC; const float* gate;
    DI void operator()(const pg8::f32x4 (&acc)[2][2][4][2], const pg8::Unit& u, int wr, int wc, int fr, int fq) const {
        const int pm = u.pm; const bool lat = pm < 128; const float* g = gate + (lat ? (pm >> 4) : 8) * 6144;
        const int row0 = pm * 256 + wr * 64 + fr, col0 = u.pn * 256 + wc * 32 + 4 * fq;
#pragma unroll
        for (int ai = 0; ai < 2; ++ai)
#pragma unroll
            for (int m = 0; m < 4; ++m) {
                const int row = row0 + 128 * ai + 16 * m;
                const float* s = lat ? srcL : srcC; float* d = lat ? dstL : dstC;
                const unsigned ro = (unsigned)(lat ? row : row - ML) * 1024u;
#pragma unroll
                for (int bj = 0; bj < 2; ++bj)
#pragma unroll
                    for (int n = 0; n < 2; ++n) {
                        const unsigned col = (unsigned)(col0 + 128 * bj + 16 * n);
                        const f32x4 xv = *(const f32x4*)(s + (ro + col)), gv = *(const f32x4*)(g + col);
                        *(f32x4*)(d + (ro + col)) = xv + gv * acc[ai][bj][m][n];
                    }
            }
    }
};
struct SplitOrder {
    int kshift, G, c;
    DI bool next(int i, pg8::Unit& u) const { const int p = i * G + c; if (p >= 128) return false; u.pm = 128 + (p >> 4); u.pn = (p >> 2) & 3; u.ko = (p & 3) << kshift; return true; }
    DI void a_ready(const pg8::Unit&) const {}
    DI void done(const pg8::Unit&) const {}
};
struct EpiPartial {
    static constexpr bool PERM = false, AFTER_DRAIN = false;
    float* PB; int kshift;
    DI void operator()(const pg8::f32x4 (&acc)[2][2][4][2], const pg8::Unit& u, int wr, int wc, int fr, int fq) const {
        float* base = PB + (size_t)(u.ko >> kshift) * MC * 1024;
        const int row0 = (u.pm - 128) * 256 + wr * 64 + fr, col0 = u.pn * 256 + wc * 32 + 4 * fq;
#pragma unroll
        for (int ai = 0; ai < 2; ++ai)
#pragma unroll
            for (int m = 0; m < 4; ++m)
#pragma unroll
                for (int bj = 0; bj < 2; ++bj)
#pragma unroll
                    for (int n = 0; n < 2; ++n)
                        *(f32x4*)(base + ((unsigned)(row0 + 128 * ai + 16 * m) * 1024u + (unsigned)(col0 + 128 * bj + 16 * n))) = acc[ai][bj][m][n];
    }
};
struct EpiFF1 {
    static constexpr bool PERM = true, AFTER_DRAIN = false;
    bf16_t* U;
    DI void operator()(const pg8::f32x4 (&acc)[2][2][4][2], const pg8::Unit& u, int wr, int wc, int fr, int fq) const {
        const int row0 = u.pm * 256 + wr * 64 + fr, col0 = u.pn * 256 + wc * 32 + 8 * fq;
#pragma unroll
        for (int ai = 0; ai < 2; ++ai)
#pragma unroll
            for (int m = 0; m < 4; ++m)
#pragma unroll
                for (int bj = 0; bj < 2; ++bj) {
                    f32x4 a0 = acc[ai][bj][m][0], a1 = acc[ai][bj][m][1];
                    a0 = __builtin_elementwise_max(a0, (f32x4){0.f, 0.f, 0.f, 0.f}); a1 = __builtin_elementwise_max(a1, (f32x4){0.f, 0.f, 0.f, 0.f});
                    a0 = a0 * a0; a1 = a1 * a1;
                    u32x4 w; w.x = pk2(a0[0], a0[1]); w.y = pk2(a0[2], a0[3]); w.z = pk2(a1[0], a1[1]); w.w = pk2(a1[2], a1[3]);
                    *(u32x4*)(U + ((unsigned)(row0 + 128 * ai + 16 * m) * 4096u + (unsigned)(col0 + 128 * bj))) = w;
                }
    }
};
constexpr float C16[16] = {1.f, 0.92387953251f, 0.70710678119f, 0.38268343237f, 0.f, -0.38268343237f, -0.70710678119f, -0.92387953251f,
                           -1.f, -0.92387953251f, -0.70710678119f, -0.38268343237f, 0.f, 0.38268343237f, 0.70710678119f, 0.92387953251f};
constexpr float S16[16] = {0.f, 0.38268343237f, 0.70710678119f, 0.92387953251f, 1.f, 0.92387953251f, 0.70710678119f, 0.38268343237f,
                           0.f, -0.38268343237f, -0.70710678119f, -0.92387953251f, -1.f, -0.92387953251f, -0.70710678119f, -0.38268343237f};
struct EpiFour {
    static constexpr bool PERM = true, AFTER_DRAIN = false;
    bf16_t* Y; int rowbase, rpb; float scale; int kind;
    DI void operator()(const pg8::f32x4 (&acc)[2][2][4][2], const pg8::Unit& u, int wr, int wc, int fr, int fq) const {
        if (kind == 0) {
            const int b = u.pn >> 4, hm = 16 * (u.pn & 15) + 4 * wc + fq;
#pragma unroll
            for (int m = 0; m < 4; ++m) {
                const int k1 = 128 * u.pm + 64 * wr + 16 * m + fr;
                float zr[16], zi[16];
#pragma unroll
                for (int n2 = 0; n2 < 16; ++n2) {
                    const float tc = acc[0][n2 >> 3][m][(n2 >> 2) & 1][n2 & 3], ts = acc[1][n2 >> 3][m][(n2 >> 2) & 1][n2 & 3];
                    const float fr_ = (float)((n2 * k1) & 4095) * (1.f / 4096.f);
                    const float c = __builtin_amdgcn_cosf(fr_), sn = __builtin_amdgcn_sinf(fr_);
                    zr[n2] = tc * c + ts * sn; zi[n2] = tc * sn - ts * c;
                }
                bf16_t* yp = Y + ((unsigned)(b * 4096 + k1) * 1024u + (unsigned)hm);
#pragma unroll
                for (int k2 = 0; k2 < 16; ++k2) {
                    float o = 0.f;
#pragma unroll
                    for (int n2 = 0; n2 < 16; ++n2) {
                        const float cc = C16[(n2 * k2) & 15], sc = S16[(n2 * k2) & 15];
                        if (cc != 0.f) o += zr[n2] * cc;
                        if (sc != 0.f) o -= zi[n2] * sc;
                    }
                    yp[(unsigned)k2 * 256u * 1024u] = f2bf(o * (1.f / 512.f));
                }
                __builtin_amdgcn_sched_barrier(0);
            }
            return;
        }
        const int row0 = rowbase + u.pn * rpb + u.pm * 256 + wr * 64 + fr, col0 = wc * 32 + 8 * fq;
#pragma unroll
        for (int ai = 0; ai < 2; ++ai)
#pragma unroll
            for (int m = 0; m < 4; ++m)
#pragma unroll
                for (int bj = 0; bj < 2; ++bj) {
                    const f32x4 a0 = acc[ai][bj][m][0] * scale, a1 = acc[ai][bj][m][1] * scale;
                    u32x4 w; w.x = pk2(a0[0], a0[1]); w.y = pk2(a0[2], a0[3]); w.z = pk2(a1[0], a1[1]); w.w = pk2(a1[2], a1[3]);
                    *(u32x4*)(Y + ((unsigned)(row0 + 128 * ai + 16 * m) * 1024u + (unsigned)(col0 + 128 * bj))) = w;
                }
    }
};

DI bf16x8 ldg8(const bf16_t* p) { return *(const bf16x8*)p; }
DI bf16x8 ldv(const bf16_t* p) { const s16x4 lo = *(const s16x4*)p, hi = *(const s16x4*)(p + 8); return __builtin_shufflevector(lo, hi, 0, 1, 2, 3, 4, 5, 6, 7); }
DI f32x16 zero16() { f32x16 z; for (int i = 0; i < 16; ++i) z[i] = 0.f; return z; }
DI void softmax_step(f32x16& s, float& m, float& l, f32x16& Oa, f32x16& Ob, bf16x8& pa, bf16x8& pb) {
    float t = s[0];
#pragma unroll
    for (int i = 1; i < 16; ++i) t = fmaxf(t, s[i]);
    t = fmaxf(t, xor32(t));
    const float mn = fmaxf(m, t), al = ex2(m - mn); m = mn;
    float sum = 0.f;
#pragma unroll
    for (int i = 0; i < 16; ++i) { const float p = s[i] > -1e29f ? ex2(s[i] - mn) : 0.f; s[i] = p; sum += p; }
    l = l * al + sum; Oa = Oa * al; Ob = Ob * al;
    u32x4 a, b;
    a.x = pk2(s[0], s[1]); a.y = pk2(s[2], s[3]); a.z = pk2(s[4], s[5]); a.w = pk2(s[6], s[7]);
    b.x = pk2(s[8], s[9]); b.y = pk2(s[10], s[11]); b.z = pk2(s[12], s[13]); b.w = pk2(s[14], s[15]);
    pa = __builtin_bit_cast(bf16x8, a); pb = __builtin_bit_cast(bf16x8, b);
}

DI float exp_sum(const f32x16& sa, const f32x16& sb, f32x16& pa, f32x16& pb) {
    f32x2 s2 = {0.f, 0.f};
#pragma unroll
    for (int i = 0; i < 16; i += 2) {
        pa[i] = ex2(sa[i]); pa[i + 1] = ex2(sa[i + 1]); pb[i] = ex2(sb[i]); pb[i + 1] = ex2(sb[i + 1]);
        s2 += (f32x2){pa[i], pa[i + 1]}; s2 += (f32x2){pb[i], pb[i + 1]};
    }
    return s2.x + s2.y;
}
DI void smax64(f32x16& sa, f32x16& sb, float& m, float& l, f32x16& Oa, f32x16& Ob, const bool first, bf16x8 (&p)[4]) {
    f32x16 pa, pb;
    float sum = exp_sum(sa, sb, pa, pb);
    if (first || __ballot(!(sum <= 65536.f)) != 0ull) {
        float t = fmaxf(sa[0], sb[0]);
#pragma unroll
        for (int i = 1; i < 16; ++i) t = fmaxf(t, fmaxf(sa[i], sb[i]));
        t = fmaxf(t, xor32(t));
        const float delta = first ? t : fmaxf(t, 0.f);
        const float al = first ? 1.f : ex2(-delta);
        m += delta; l *= al; Oa = Oa * al; Ob = Ob * al;
#pragma unroll
        for (int i = 0; i < 16; ++i) { sa[i] -= delta; sb[i] -= delta; }
        sum = exp_sum(sa, sb, pa, pb);
    }
    l += sum;
    u32x4 w;
    w.x = pk2(pa[0], pa[1]); w.y = pk2(pa[2], pa[3]); w.z = pk2(pa[4], pa[5]); w.w = pk2(pa[6], pa[7]); p[0] = __builtin_bit_cast(bf16x8, w);
    w.x = pk2(pa[8], pa[9]); w.y = pk2(pa[10], pa[11]); w.z = pk2(pa[12], pa[13]); w.w = pk2(pa[14], pa[15]); p[1] = __builtin_bit_cast(bf16x8, w);
    w.x = pk2(pb[0], pb[1]); w.y = pk2(pb[2], pb[3]); w.z = pk2(pb[4], pb[5]); w.w = pk2(pb[6], pb[7]); p[2] = __builtin_bit_cast(bf16x8, w);
    w.x = pk2(pb[8], pb[9]); w.y = pk2(pb[10], pb[11]); w.z = pk2(pb[12], pb[13]); w.w = pk2(pb[14], pb[15]); p[3] = __builtin_bit_cast(bf16x8, w);
}
DI bf16x8 ldsv(const LAS unsigned char* p) { const s16x4 lo = *(const LAS s16x4*)p, hi = *(const LAS s16x4*)(p + 16); return __builtin_shufflevector(lo, hi, 0, 1, 2, 3, 4, 5, 6, 7); }

constexpr int DKB = 9216, DBUF = 17920;
DI void diff_item(const Args& A, int l, int b, int h, int qb, LAS unsigned char* lds, const int tid) {
    const int lane = tid & 63, wid = tid >> 6, lh = lane >> 5, ln = lane & 31;
    const bf16_t* Q = (const bf16_t*)(A.ws + WS_DFQ); const bf16_t* K = (const bf16_t*)(A.ws + WS_DFK);
    const bf16_t* VT = (const bf16_t*)(A.ws + WS_DFVT) + (size_t)(b * 256 + h * 64) * KV;
    const int qrow = (qb >= 0 ? b * 4096 + qb * 256 : ML + b * 256) + wid * 32 + ln;
    const bf16_t* qp = Q + (size_t)qrow * 256 + h * 64 + 8 * lh;
    const bf16x8 q1a = ldg8(qp), q1b = ldg8(qp + 16), q2a = ldg8(qp + 32), q2b = ldg8(qp + 48);
    const int lk = tid >> 3, lc = tid & 7;
    const bf16_t* kgL = K + (size_t)(b * 4096 + lk) * 256 + h * 64 + lc * 8;
    const bf16_t* kgC = K + (size_t)(ML + b * 256 + lk) * 256 + h * 64 + lc * 8;
    const bf16_t* vg = VT + (size_t)lk * KV + lc * 8;
    LAS unsigned char* kw = lds + lk * 144 + lc * 16;
    LAS unsigned char* vw = lds + DKB + lk * 136 + lc * 16;
    const LAS unsigned char* kr = lds + ln * 144 + lh * 16;
    const LAS unsigned char* vr = lds + DKB + ln * 136 + lh * 8;
    const int st0 = qb >= 0 ? 0 : 64;
    f32x16 O1a = zero16(), O1b = zero16(), O2a = zero16(), O2b = zero16();
    float m1 = 0.f, l1 = 0.f, m2 = 0.f, l2 = 0.f;
    __syncthreads();
    {
        const bf16x8 kreg = ldg8(st0 < 64 ? kgL + (size_t)st0 * 64 * 256 : kgC + (size_t)(st0 - 64) * 64 * 256);
        const bf16x8 vreg = ldg8(vg + st0 * 64);
        *(LAS bf16x8*)kw = kreg;
        const u32x4 vv = __builtin_bit_cast(u32x4, vreg);
        *(LAS u32x2*)vw = (u32x2){vv.x, vv.y}; *(LAS u32x2*)(vw + 8) = (u32x2){vv.z, vv.w};
    }
    __syncthreads();
    for (int st = st0; st < 68; ++st) {
        const int cur = (st - st0) & 1; const bool more = st + 1 < 68, first = st == st0;
        bf16x8 kreg, vreg;
        if (more) { const int sn = st + 1; kreg = ldg8(sn < 64 ? kgL + (size_t)sn * 64 * 256 : kgC + (size_t)(sn - 64) * 64 * 256); vreg = ldg8(vg + sn * 64); }
        const LAS unsigned char* kb = kr + cur * DBUF; const LAS unsigned char* vb = vr + cur * DBUF;
        f32x16 ng1, ng2; { const float n1 = -m1, n2 = -m2;
#pragma unroll
          for (int i = 0; i < 16; ++i) { ng1[i] = n1; ng2[i] = n2; } }
        f32x16 s1a = MFMA32(*(const LAS bf16x8*)(kb), q1a, ng1); s1a = MFMA32(*(const LAS bf16x8*)(kb + 32), q1b, s1a);
        f32x16 s1b = MFMA32(*(const LAS bf16x8*)(kb + 32 * 144), q1a, ng1); s1b = MFMA32(*(const LAS bf16x8*)(kb + 32 * 144 + 32), q1b, s1b);
        f32x16 s2a = MFMA32(*(const LAS bf16x8*)(kb + 64), q2a, ng2); s2a = MFMA32(*(const LAS bf16x8*)(kb + 96), q2b, s2a);
        f32x16 s2b = MFMA32(*(const LAS bf16x8*)(kb + 32 * 144 + 64), q2a, ng2); s2b = MFMA32(*(const LAS bf16x8*)(kb + 32 * 144 + 96), q2b, s2b);
        bf16x8 p[4], r[4];
        smax64(s1a, s1b, m1, l1, O1a, O1b, first, p);
#pragma unroll
        for (int j = 0; j < 2; ++j) {
            O1a = MFMA32(ldsv(vb + 64 * j), p[2 * j], O1a); O1a = MFMA32(ldsv(vb + 64 * j + 32), p[2 * j + 1], O1a);
            O1b = MFMA32(ldsv(vb + 32 * 136 + 64 * j), p[2 * j], O1b); O1b = MFMA32(ldsv(vb + 32 * 136 + 64 * j + 32), p[2 * j + 1], O1b);
        }
        smax64(s2a, s2b, m2, l2, O2a, O2b, first, r);
#pragma unroll
        for (int j = 0; j < 2; ++j) {
            O2a = MFMA32(ldsv(vb + 64 * j), r[2 * j], O2a); O2a = MFMA32(ldsv(vb + 64 * j + 32), r[2 * j + 1], O2a);
            O2b = MFMA32(ldsv(vb + 32 * 136 + 64 * j), r[2 * j], O2b); O2b = MFMA32(ldsv(vb + 32 * 136 + 64 * j + 32), r[2 * j + 1], O2b);
        }
        if (more) {
            *(LAS bf16x8*)(kw + (cur ^ 1) * DBUF) = kreg;
            const u32x4 vv = __builtin_bit_cast(u32x4, vreg);
            *(LAS u32x2*)(vw + (cur ^ 1) * DBUF) = (u32x2){vv.x, vv.y}; *(LAS u32x2*)(vw + (cur ^ 1) * DBUF + 8) = (u32x2){vv.z, vv.w};
        }
        __syncthreads();
    }
    l1 += xor32(l1); l2 += xor32(l2);
    const float* lt = (const float*)(A.ws + WS_LAM);
    const float i1 = 1.f / l1, i2 = lt[2 * l] / l2, oml = lt[2 * l + 1];
    float ss = 0.f;
#pragma unroll
    for (int i = 0; i < 16; ++i) { O1a[i] = O1a[i] * i1 - O2a[i] * i2; O1b[i] = O1b[i] * i1 - O2b[i] * i2; ss += O1a[i] * O1a[i] + O1b[i] * O1b[i]; }
    ss += xor32(ss);
    const float rn = rsqrtf(ss * (1.f / 64.f) + 1e-6f) * oml;
    const float* g = A.in[19] + l * 64;
    bf16_t* Y = (bf16_t*)(A.ws + WS_H) + (size_t)qrow * 1024 + 768 + h * 64;
#pragma unroll
    for (int ig = 0; ig < 4; ++ig) {
        const int d = 8 * ig + 4 * lh;
        const f32x4 ga = *(const f32x4*)(g + d), gb = *(const f32x4*)(g + 32 + d);
        u32x2 wa, wb;
        wa.x = pk2(O1a[4 * ig] * rn * ga.x, O1a[4 * ig + 1] * rn * ga.y); wa.y = pk2(O1a[4 * ig + 2] * rn * ga.z, O1a[4 * ig + 3] * rn * ga.w);
        wb.x = pk2(O1b[4 * ig] * rn * gb.x, O1b[4 * ig + 1] * rn * gb.y); wb.y = pk2(O1b[4 * ig + 2] * rn * gb.z, O1b[4 * ig + 3] * rn * gb.w);
        *(u32x2*)(Y + d) = wa; *(u32x2*)(Y + 32 + d) = wb;
    }
}

DI void na_item(const Args& A, int l, int b, int h, int rb, LAS unsigned char* lds, LAS float* rpb_s, const int tid) {
    const int lane = tid & 63, wid = __builtin_amdgcn_readfirstlane(tid >> 6), lh = lane >> 5, ln = lane & 31;
    __syncthreads();
    for (int i = tid; i < 465; i += 512) rpb_s[i] = A.in[10][(l * 4 + h) * 465 + i] * LOG2E;
    const bf16_t* Q = (const bf16_t*)(A.ws + WS_NAQ); const bf16_t* K = (const bf16_t*)(A.ws + WS_NAK);
    const bf16_t* VT = (const bf16_t*)(A.ws + WS_NAVT) + (size_t)(b * 256 + h * 64) * KV;
    const bool lat = rb >= 0;
    const int r = rb * 4 + (wid >> 1), qc = (wid & 1) * 32 + ln;
    const int qrow = lat ? b * 4096 + r * 64 + qc : ML + b * 256 + wid * 32 + ln;
    const bf16_t* qp = Q + (size_t)qrow * 256 + h * 64 + 8 * lh;
    const bf16x8 q0 = ldg8(qp), q1 = ldg8(qp + 16), q2 = ldg8(qp + 32), q3 = ldg8(qp + 48);
    const int rs = min(max(r - 4, 0), 56), cs = min(max(qc - 8, 0), 48);
    const int rmin = lat ? min(max(4 * rb - 4, 0), 56) : 0;
    const int nloc = lat ? min(max(4 * rb - 1, 0), 56) + 8 - rmin : 0;
    const int nst = nloc + 4;
    const int lk = tid >> 3, lc = tid & 7;
    const bf16_t* kgL = K + (size_t)(b * 4096 + rmin * 64 + lk) * 256 + h * 64 + lc * 8;
    const bf16_t* kgC = K + (size_t)(ML + b * 256 + lk) * 256 + h * 64 + lc * 8;
    const bf16_t* vg = VT + (size_t)lk * KV + lc * 8;
    LAS unsigned char* kw = lds + lk * 144 + lc * 16;
    LAS unsigned char* vw = lds + DKB + lk * 136 + lc * 16;
    const LAS unsigned char* kr = lds + ln * 144 + lh * 16;
    const LAS unsigned char* vr = lds + DKB + ln * 136 + lh * 8;
    f32x16 Oa = zero16(), Ob = zero16(); float m = 0.f, ls = 0.f; bool started = false;
    {
        const bf16x8 kreg = ldg8(nloc > 0 ? kgL : kgC);
        const bf16x8 vreg = ldg8(vg + (nloc > 0 ? rmin * 64 : 4096));
        *(LAS bf16x8*)kw = kreg;
        const u32x4 vv = __builtin_bit_cast(u32x4, vreg);
        *(LAS u32x2*)vw = (u32x2){vv.x, vv.y}; *(LAS u32x2*)(vw + 8) = (u32x2){vv.z, vv.w};
    }
    __syncthreads();
    for (int j = 0; j < nst; ++j) {
        const int cur = j & 1; const bool more = j + 1 < nst;
        bf16x8 kreg, vreg;
        if (more) { const int jn = j + 1; kreg = ldg8(jn < nloc ? kgL + (size_t)jn * 64 * 256 : kgC + (size_t)(jn - nloc) * 64 * 256); vreg = ldg8(vg + (jn < nloc ? (rmin + jn) * 64 : 4096 + (jn - nloc) * 64)); }
        const bool loc = j < nloc; const int krow = rmin + j;
        if (!loc || (krow >= rs && krow < rs + 8)) {
            const LAS unsigned char* kb = kr + cur * DBUF; const LAS unsigned char* vb = vr + cur * DBUF;
            f32x16 sa = MFMA32(*(const LAS bf16x8*)(kb), q0, zero16()); sa = MFMA32(*(const LAS bf16x8*)(kb + 32), q1, sa);
            sa = MFMA32(*(const LAS bf16x8*)(kb + 64), q2, sa); sa = MFMA32(*(const LAS bf16x8*)(kb + 96), q3, sa);
            f32x16 sb = MFMA32(*(const LAS bf16x8*)(kb + 32 * 144), q0, zero16()); sb = MFMA32(*(const LAS bf16x8*)(kb + 32 * 144 + 32), q1, sb);
            sb = MFMA32(*(const LAS bf16x8*)(kb + 32 * 144 + 64), q2, sb); sb = MFMA32(*(const LAS bf16x8*)(kb + 32 * 144 + 96), q3, sb);
            if (loc) {
                const int dr = krow - r + 7;
#pragma unroll
                for (int i = 0; i < 16; ++i) {
                    const int kc = (i & 3) + 8 * (i >> 2) + 4 * lh;
                    const bool va = kc >= cs && kc < cs + 16, vb2 = kc + 32 >= cs && kc + 32 < cs + 16;
                    const int da = min(max(kc - qc + 15, 0), 30), db = min(max(kc + 32 - qc + 15, 0), 30);
                    sa[i] = va ? sa[i] + rpb_s[dr * 31 + da] - m : -1e30f;
                    sb[i] = vb2 ? sb[i] + rpb_s[dr * 31 + db] - m : -1e30f;
                }
            } else {
#pragma unroll
                for (int i = 0; i < 16; ++i) { sa[i] -= m; sb[i] -= m; }
            }
            bf16x8 p[4];
            smax64(sa, sb, m, ls, Oa, Ob, !started, p); started = true;
#pragma unroll
            for (int jj = 0; jj < 2; ++jj) {
                Oa = MFMA32(ldsv(vb + 64 * jj), p[2 * jj], Oa); Oa = MFMA32(ldsv(vb + 64 * jj + 32), p[2 * jj + 1], Oa);
                Ob = MFMA32(ldsv(vb + 32 * 136 + 64 * jj), p[2 * jj], Ob); Ob = MFMA32(ldsv(vb + 32 * 136 + 64 * jj + 32), p[2 * jj + 1], Ob);
            }
        }
        if (more) {
            *(LAS bf16x8*)(kw + (cur ^ 1) * DBUF) = kreg;
            const u32x4 vv = __builtin_bit_cast(u32x4, vreg);
            *(LAS u32x2*)(vw + (cur ^ 1) * DBUF) = (u32x2){vv.x, vv.y}; *(LAS u32x2*)(vw + (cur ^ 1) * DBUF + 8) = (u32x2){vv.z, vv.w};
        }
        __syncthreads();
    }
    ls += xor32(ls);
    const float inv = 1.f / ls;
    bf16_t* Y = (bf16_t*)(A.ws + WS_H) + (size_t)qrow * 1024 + 256 + h * 64;
#pragma unroll
    for (int ig = 0; ig < 4; ++ig) {
        const int d = 8 * ig + 4 * lh;
        u32x2 wa, wb;
        wa.x = pk2(Oa[4 * ig] * inv, Oa[4 * ig + 1] * inv); wa.y = pk2(Oa[4 * ig + 2] * inv, Oa[4 * ig + 3] * inv);
        wb.x = pk2(Ob[4 * ig] * inv, Ob[4 * ig + 1] * inv); wb.y = pk2(Ob[4 * ig + 2] * inv, Ob[4 * ig + 3] * inv);
        *(u32x2*)(Y + d) = wa; *(u32x2*)(Y + 32 + d) = wb;
    }
}

DI void smax32(f32x16& sa, float& m, float& l, f32x16& Oa, f32x16& Ob, bool& started, bf16x8 (&p)[2]) {
    f32x16 pa; f32x2 s2 = {0.f, 0.f};
#pragma unroll
    for (int i = 0; i < 16; i += 2) { pa[i] = ex2(sa[i]); pa[i + 1] = ex2(sa[i + 1]); s2 += (f32x2){pa[i], pa[i + 1]}; }
    float sum = s2.x + s2.y;
    if (__ballot(!(sum <= 65536.f) || !started) != 0ull) {
        float t = sa[0];
#pragma unroll
        for (int i = 1; i < 16; ++i) t = fmaxf(t, sa[i]);
        t = fmaxf(t, xor32(t));
        const bool has = t > -1e29f;
        const float delta = started ? fmaxf(t, 0.f) : (has ? t : 0.f);
        const float al = started ? ex2(-delta) : 1.f;
        m += delta; l *= al; Oa = Oa * al; Ob = Ob * al;
        started = started || has;
        s2 = (f32x2){0.f, 0.f};
#pragma unroll
        for (int i = 0; i < 16; i += 2) { pa[i] = ex2(sa[i] - delta); pa[i + 1] = ex2(sa[i + 1] - delta); s2 += (f32x2){pa[i], pa[i + 1]}; }
        sum = s2.x + s2.y;
    }
    l += sum;
    u32x4 w;
    w.x = pk2(pa[0], pa[1]); w.y = pk2(pa[2], pa[3]); w.z = pk2(pa[4], pa[5]); w.w = pk2(pa[6], pa[7]); p[0] = __builtin_bit_cast(bf16x8, w);
    w.x = pk2(pa[8], pa[9]); w.y = pk2(pa[10], pa[11]); w.z = pk2(pa[12], pa[13]); w.w = pk2(pa[14], pa[15]); p[1] = __builtin_bit_cast(bf16x8, w);
}

DI void na_item_lat(const Args& A, int l, int b, int h, int rb, LAS unsigned char* lds, LAS float* rpb_s, const int tid) {
    const int lane = tid & 63, wid = __builtin_amdgcn_readfirstlane(tid >> 6), lh = lane >> 5, ln = lane & 31;
    __syncthreads();
    for (int i = tid; i < 465; i += 512) rpb_s[i] = A.in[10][(l * 4 + h) * 465 + i] * LOG2E;
    const bf16_t* Q = (const bf16_t*)(A.ws + WS_NAQ); const bf16_t* K = (const bf16_t*)(A.ws + WS_NAK);
    const bf16_t* VT = (const bf16_t*)(A.ws + WS_NAVT) + (size_t)(b * 256 + h * 64) * KV;
    const int ra = rb * 4 + 2 * (wid >> 2), jg = wid & 3;
    const int r = ra + (ln >> 4), qc = 16 * jg + (ln & 15);
    const int qrow = b * 4096 + r * 64 + qc;
    const bf16_t* qp = Q + (size_t)qrow * 256 + h * 64 + 8 * lh;
    const bf16x8 q0 = ldg8(qp), q1 = ldg8(qp + 16), q2 = ldg8(qp + 32), q3 = ldg8(qp + 48);
    const int rsl = min(max(r - 4, 0), 56), cs = min(max(qc - 8, 0), 48);
    const int w0 = min(max(ra - 4, 0), 56), w1 = min(max(ra - 3, 0), 56) + 8;
    const int t0 = min(max(16 * jg - 8, 0), 32);
    unsigned cmask = 0u;
#pragma unroll
    for (int i = 0; i < 16; ++i) { const int kc = t0 + (i & 3) + 8 * (i >> 2) + 4 * lh; cmask |= (kc >= cs && kc < cs + 16) ? (1u << i) : 0u; }
    const int cbase = t0 + 4 * lh - qc + 15;
    const int rmin = min(max(4 * rb - 4, 0), 56);
    const int nloc = min(max(4 * rb - 1, 0), 56) + 8 - rmin;
    const int nst = nloc + 4;
    const int lk = tid >> 3, lc = tid & 7;
    const bf16_t* kgL = K + (size_t)(b * 4096 + rmin * 64 + lk) * 256 + h * 64 + lc * 8;
    const bf16_t* kgC = K + (size_t)(ML + b * 256 + lk) * 256 + h * 64 + lc * 8;
    const bf16_t* vg = VT + (size_t)lk * KV + lc * 8;
    LAS unsigned char* kw = lds + lk * 144 + lc * 16;
    LAS unsigned char* vw = lds + DKB + lk * 136 + lc * 16;
    const LAS unsigned char* kr = lds + ln * 144 + lh * 16;
    const LAS unsigned char* vr = lds + DKB + ln * 136 + lh * 8;
    f32x16 Oa = zero16(), Ob = zero16(); float m = 0.f, ls = 0.f; bool started = false;
#define NA_KSRC(jn) ((jn) < nloc ? kgL + (size_t)(jn) * 64 * 256 : kgC + (size_t)((jn) - nloc) * 64 * 256)
#define NA_VSRC(jn) (vg + ((jn) < nloc ? (rmin + (jn)) * 64 : 4096 + ((jn) - nloc) * 64))
    bf16x8 kA, vA, kB, vB;
    {
        const bf16x8 kreg = ldg8(NA_KSRC(0));
        const bf16x8 vreg = ldg8(NA_VSRC(0));
        kA = ldg8(NA_KSRC(1)); vA = ldg8(NA_VSRC(1));
        *(LAS bf16x8*)kw = kreg;
        const u32x4 vv = __builtin_bit_cast(u32x4, vreg);
        *(LAS u32x2*)vw = (u32x2){vv.x, vv.y}; *(LAS u32x2*)(vw + 8) = (u32x2){vv.z, vv.w};
    }
    kB = kA; vB = vA;
    __syncthreads();
    for (int j = 0; j < nst; ++j) {
        const int cur = j & 1; const bool more = j + 1 < nst;
        if (j + 2 < nst) { kB = ldg8(NA_KSRC(j + 2)); vB = ldg8(NA_VSRC(j + 2)); }
        const bool loc = j < nloc; const int krow = rmin + j;
        const LAS unsigned char* kb = kr + cur * DBUF; const LAS unsigned char* vb = vr + cur * DBUF;
        if (loc) {
            if (krow >= w0 && krow < w1) {
                const LAS unsigned char* kt = kb + t0 * 144; const LAS unsigned char* vt = vb + t0 * 2;
                f32x16 sa = MFMA32(*(const LAS bf16x8*)(kt), q0, zero16()); sa = MFMA32(*(const LAS bf16x8*)(kt + 32), q1, sa);
                sa = MFMA32(*(const LAS bf16x8*)(kt + 64), q2, sa); sa = MFMA32(*(const LAS bf16x8*)(kt + 96), q3, sa);
                const bool rv = krow >= rsl && krow < rsl + 8;
                const LAS float* rp = rpb_s + ((krow - r + 7) * 31 + cbase);
#pragma unroll
                for (int i = 0; i < 16; ++i) sa[i] = (rv && ((cmask >> i) & 1u)) ? sa[i] + rp[(i & 3) + 8 * (i >> 2)] - m : -1e30f;
                bf16x8 p[2];
                smax32(sa, m, ls, Oa, Ob, started, p);
                Oa = MFMA32(ldsv(vt), p[0], Oa); Oa = MFMA32(ldsv(vt + 32), p[1], Oa);
                Ob = MFMA32(ldsv(vt + 32 * 136), p[0], Ob); Ob = MFMA32(ldsv(vt + 32 * 136 + 32), p[1], Ob);
            }
        } else {
            f32x16 sa = MFMA32(*(const LAS bf16x8*)(kb), q0, zero16()); sa = MFMA32(*(const LAS bf16x8*)(kb + 32), q1, sa);
            sa = MFMA32(*(const LAS bf16x8*)(kb + 64), q2, sa); sa = MFMA32(*(const LAS bf16x8*)(kb + 96), q3, sa);
            f32x16 sb = MFMA32(*(const LAS bf16x8*)(kb + 32 * 144), q0, zero16()); sb = MFMA32(*(const LAS bf16x8*)(kb + 32 * 144 + 32), q1, sb);
            sb = MFMA32(*(const LAS bf16x8*)(kb + 32 * 144 + 64), q2, sb); sb = MFMA32(*(const LAS bf16x8*)(kb + 32 * 144 + 96), q3, sb);
#pragma unroll
            for (int i = 0; i < 16; ++i) { sa[i] -= m; sb[i] -= m; }
            bf16x8 p[4];
            smax64(sa, sb, m, ls, Oa, Ob, false, p);
#pragma unroll
            for (int jj = 0; jj < 2; ++jj) {
                Oa = MFMA32(ldsv(vb + 64 * jj), p[2 * jj], Oa); Oa = MFMA32(ldsv(vb + 64 * jj + 32), p[2 * jj + 1], Oa);
                Ob = MFMA32(ldsv(vb + 32 * 136 + 64 * jj), p[2 * jj], Ob); Ob = MFMA32(ldsv(vb + 32 * 136 + 64 * jj + 32), p[2 * jj + 1], Ob);
            }
        }
        if (more) {
            *(LAS bf16x8*)(kw + (cur ^ 1) * DBUF) = kA;
            const u32x4 vv = __builtin_bit_cast(u32x4, vA);
            *(LAS u32x2*)(vw + (cur ^ 1) * DBUF) = (u32x2){vv.x, vv.y}; *(LAS u32x2*)(vw + (cur ^ 1) * DBUF + 8) = (u32x2){vv.z, vv.w};
        }
        __syncthreads();
        kA = kB; vA = vB;
    }
#undef NA_KSRC
#undef NA_VSRC
    ls += xor32(ls);
    const float inv = 1.f / ls;
    bf16_t* Y = (bf16_t*)(A.ws + WS_H) + (size_t)qrow * 1024 + 256 + h * 64;
#pragma unroll
    for (int ig = 0; ig < 4; ++ig) {
        const int d = 8 * ig + 4 * lh;
        u32x2 wa, wb;
        wa.x = pk2(Oa[4 * ig] * inv, Oa[4 * ig + 1] * inv); wa.y = pk2(Oa[4 * ig + 2] * inv, Oa[4 * ig + 3] * inv);
        wb.x = pk2(Ob[4 * ig] * inv, Ob[4 * ig + 1] * inv); wb.y = pk2(Ob[4 * ig + 2] * inv, Ob[4 * ig + 3] * inv);
        *(u32x2*)(Y + d) = wa; *(u32x2*)(Y + 32 + d) = wb;
    }
}

DI void sgu_item(const Args& A, int l, int ci, LAS unsigned char* lds, const int tid) {
    const int lane = tid & 63, wid = __builtin_amdgcn_readfirstlane(tid >> 6), lh = lane >> 5, ln = lane & 31;
    const int row0 = ci * 128;
    LAS bf16_t* vT = (LAS bf16_t*)lds;
    const bf16_t* SV = (const bf16_t*)(A.ws + WS_SGV); const bf16_t* SU = (const bf16_t*)(A.ws + WS_SGU);
    const f32x4 lg = *(const f32x4*)(A.in[11] + l * 256 + lane * 4), lb = *(const f32x4*)(A.in[12] + l * 256 + lane * 4);
    const int g = wid >> 1, ph = wid & 1;
    bf16x8 bfr[2][8];
    {
        const bf16_t* Wb = (const bf16_t*)(A.ws + WS_SGW) + (size_t)((l * 4 + g) * 128 + 64 * ph + ln) * 128 + 8 * lh;
#pragma unroll
        for (int pt = 0; pt < 2; ++pt)
#pragma unroll
            for (int ks = 0; ks < 8; ++ks) bfr[pt][ks] = ldg8(Wb + (size_t)pt * 32 * 128 + 16 * ks);
    }
    __syncthreads();
#pragma unroll 1
    for (int i4 = 0; i4 < 4; ++i4) {
        const int q0 = wid * 16 + 4 * i4;
        float x[4][4], mu[4], var[4];
#pragma unroll
        for (int rr = 0; rr < 4; ++rr) {
            const u32x2 raw = *(const u32x2*)(SV + (size_t)(row0 + q0 + rr) * 256 + lane * 4);
            x[rr][0] = bf2f(raw.x & 0xffffu); x[rr][1] = bf2f(raw.x >> 16); x[rr][2] = bf2f(raw.y & 0xffffu); x[rr][3] = bf2f(raw.y >> 16);
            mu[rr] = x[rr][0] + x[rr][1] + x[rr][2] + x[rr][3];
        }
#pragma unroll
        for (int o = 32; o > 0; o >>= 1)
#pragma unroll
            for (int rr = 0; rr < 4; ++rr) mu[rr] += __shfl_xor(mu[rr], o);
#pragma unroll
        for (int rr = 0; rr < 4; ++rr) {
            mu[rr] *= (1.f / 256.f);
#pragma unroll
            for (int j = 0; j < 4; ++j) x[rr][j] -= mu[rr];
            var[rr] = x[rr][0] * x[rr][0] + x[rr][1] * x[rr][1] + x[rr][2] * x[rr][2] + x[rr][3] * x[rr][3];
        }
#pragma unroll
        for (int o = 32; o > 0; o >>= 1)
#pragma unroll
            for (int rr = 0; rr < 4; ++rr) var[rr] += __shfl_xor(var[rr], o);
        float rn[4];
#pragma unroll
        for (int rr = 0; rr < 4; ++rr) rn[rr] = rsqrtf(var[rr] * (1.f / 256.f) + 1e-6f);
#pragma unroll
        for (int j = 0; j < 4; ++j) {
            const float gj = lg[j], bj = lb[j];
            u32x2 w; w.x = pk2(x[0][j] * rn[0] * gj + bj, x[1][j] * rn[1] * gj + bj); w.y = pk2(x[2][j] * rn[2] * gj + bj, x[3][j] * rn[3] * gj + bj);
            *(LAS u32x2*)(vT + (lane * 4 + j) * 136 + q0) = w;
        }
    }
    __syncthreads();
    f32x16 acc[2][2];
#pragma unroll
    for (int ct = 0; ct < 2; ++ct)
#pragma unroll
        for (int pt = 0; pt < 2; ++pt) acc[ct][pt] = zero16();
#pragma unroll
    for (int ks = 0; ks < 8; ++ks) {
        bf16x8 af[2];
#pragma unroll
        for (int ct = 0; ct < 2; ++ct) af[ct] = *(const LAS bf16x8*)(vT + (g * 64 + 32 * ct + ln) * 136 + 16 * ks + 8 * lh);
#pragma unroll
        for (int ct = 0; ct < 2; ++ct)
#pragma unroll
            for (int pt = 0; pt < 2; ++pt) acc[ct][pt] = MFMA32(af[ct], bfr[pt][ks], acc[ct][pt]);
    }
    bf16_t* Y = (bf16_t*)(A.ws + WS_H);
#pragma unroll
    for (int pt = 0; pt < 2; ++pt) {
        const int p = 64 * ph + 32 * pt + ln;
        const float bias = A.in[14][(l * 4 + g) * 128 + p];
#pragma unroll
        for (int ct = 0; ct < 2; ++ct)
#pragma unroll
            for (int ig = 0; ig < 4; ++ig) {
                const int c = g * 64 + 32 * ct + 8 * ig + 4 * lh;
                const u32x2 raw = *(const u32x2*)(SU + (size_t)(row0 + p) * 256 + c);
                const float u0 = bf2f(raw.x & 0xffffu), u1 = bf2f(raw.x >> 16), u2 = bf2f(raw.y & 0xffffu), u3 = bf2f(raw.y >> 16);
                u32x2 o; o.x = pk2(u0 * (acc[ct][pt][4 * ig] + bias), u1 * (acc[ct][pt][4 * ig + 1] + bias));
                o.y = pk2(u2 * (acc[ct][pt][4 * ig + 2] + bias), u3 * (acc[ct][pt][4 * ig + 3] + bias));
                *(u32x2*)(Y + (size_t)(row0 + p) * 1024 + 512 + c) = o;
            }
    }
}

#define XB_TMO      128
#define XB_XCNT(j)  (256  + 64 * (j))
#define XB_XSUB(j)  (1280 + 64 * (j))
#define XB_XGEN(j)  (2304 + 64 * (j))
#define XB_TOP      3328
#define XB_TOPGEN   3392
#define XCD_BAR_WORDS 3456
#define XB_SPIN_CAP (1u << 18)

__device__ __forceinline__ unsigned xb_ld(unsigned* p)              { return __hip_atomic_load(p, __ATOMIC_RELAXED, __HIP_MEMORY_SCOPE_AGENT); }
__device__ __forceinline__ unsigned xb_add(unsigned* p, unsigned v) { return __hip_atomic_fetch_add(p, v, __ATOMIC_RELAXED, __HIP_MEMORY_SCOPE_AGENT); }
__device__ __forceinline__ unsigned xb_xcc_id() { return (unsigned)__builtin_amdgcn_s_getreg((3 << 11) | 20) & 0xFu; }
#define XB_SPIN(cond, bar) do { unsigned _sp = 0; while (cond) { __builtin_amdgcn_s_sleep(1); \
    if ((++_sp & 255u) == 0u) { if (xb_ld(&(bar)[XB_TMO])) break; if (_sp > XB_SPIN_CAP) { atomicAdd(&(bar)[XB_TMO], 1u); break; } } } } while (0)

struct XcdBarrier {
    unsigned* bar; unsigned x;
    volatile LAS unsigned* st;
};

__device__ __forceinline__ XcdBarrier xcd_barrier_post(unsigned* bar, volatile LAS unsigned* st) {
    XcdBarrier b; b.bar = bar; b.x = xb_xcc_id(); b.st = st;
    if (threadIdx.x == 0) (void)xb_add(&bar[XB_XCNT(b.x)], 1u);
    return b;
}
__device__ __forceinline__ void xcd_barrier_complete(unsigned* bar, unsigned x, unsigned& nloc, unsigned& nx) {
    const unsigned G = gridDim.x * gridDim.y * gridDim.z;
    unsigned sum, cnt, mine, sp = 0u;
    for (;;) {
        sum = 0u; cnt = 0u; mine = 0u;
#pragma unroll
        for (unsigned j = 0; j < 16; ++j) { const unsigned c = xb_ld(&bar[XB_XCNT(j)]); sum += c; cnt += (c > 0u) ? 1u : 0u; mine = (j == x) ? c : mine; }
        if (sum == G) break;
        __builtin_amdgcn_s_sleep(1);
        if ((++sp & 255u) == 0u) { if (xb_ld(&bar[XB_TMO])) break; if (sp > XB_SPIN_CAP) { atomicAdd(&bar[XB_TMO], 1u); break; } }
    }
    nloc = mine > 0u ? mine : 1u; nx = cnt > 0u ? cnt : 1u;
}

__device__ __forceinline__ void xcd_barrier(const XcdBarrier& b) {
    asm volatile("s_waitcnt vmcnt(0)" ::: "memory");
    __syncthreads();
    if (threadIdx.x == 0) {
        unsigned* bar = b.bar;
        __builtin_amdgcn_s_waitcnt(0);
        unsigned nloc = b.st[0], nx = b.st[1];
        if (nloc == 0u) { xcd_barrier_complete(bar, b.x, nloc, nx); b.st[0] = nloc; b.st[1] = nx; }
        const unsigned old = xb_add(&bar[XB_XSUB(b.x)], 1u);
        const unsigned gen = old / nloc;
        if (old + 1u == (gen + 1u) * nloc) {
            __builtin_amdgcn_fence(__ATOMIC_RELEASE, "agent");
            asm volatile("s_waitcnt vmcnt(0)" ::: "memory");
            const unsigned og = xb_add(&bar[XB_TOP], 1u);
            const unsigned tg = og / nx;
            if (og + 1u == (tg + 1u) * nx) xb_add(&bar[XB_TOPGEN], 1u);
            else XB_SPIN(xb_ld(&bar[XB_TOPGEN]) == tg, bar);
            __builtin_amdgcn_fence(__ATOMIC_ACQUIRE, "agent");
            xb_add(&bar[XB_XGEN(b.x)], 1u);
            asm volatile("s_waitcnt vmcnt(0)" ::: "memory");
        } else {
            XB_SPIN(xb_ld(&bar[XB_XGEN(b.x)]) == gen, bar);
            __builtin_amdgcn_fence(__ATOMIC_ACQUIRE, "agent");
            asm volatile("s_waitcnt vmcnt(0)" ::: "memory");
        }
    }
    __syncthreads();
}

DI void phase_mix(const Args& A, int l, LAS unsigned char* lds, int rep) {
    const bool last = l == DEPTH - 1;
    const int nF = 256, nD = 512, nN = 512, nS = last ? 256 : 272, nFc = last ? 0 : 8, nDc = last ? 0 : 32, nNc = last ? 0 : 32;
    const int e0 = nF, e1 = e0 + nD, e2 = e1 + nN, e3 = e2 + nS, e4 = e3 + nFc, e5 = e4 + nDc, e6 = e5 + nNc, e7 = e6 + (last ? 0 : 704);
    unsigned* ctr = (unsigned*)(A.ws + WS_CTL) + l * 64 + rep * 16;
    LAS int* s_item = (LAS int*)(lds + MISC_OFF);
    LAS float* rpb_s = (LAS float*)(lds + RPB_OFF);
    bf16_t* Y = (bf16_t*)(A.ws + WS_H);
    for (;;) {
        __syncthreads();
        if (threadIdx.x == 0) *s_item = (int)atomicAdd(ctr, 1u);
        __syncthreads();
        const int it = *s_item;
        if (it >= e7) break;
        int tid = threadIdx.x; asm volatile("" : "+v"(tid));
#if PROBE_KIND >= 0
        { const int kind = (it < e0 || (it >= e3 && it < e4)) ? 0 : ((it < e1 || (it >= e4 && it < e5)) ? 1 : (it < e3 ? 3 : 2)); if (rep && kind != PROBE_KIND) continue; }
#endif
        if (it < e0 || (it >= e3 && it < e4)) {
            const bool c = it >= e3;
            pg8::Gemm g{(const bf16_t*)(A.ws + (c ? WS_CSC : WS_CS)), (const bf16_t*)(A.ws + (c ? WS_PQTC : WS_PQT)), c ? 256 : 512, c ? 2048 : 32768, 512};
            OneUnit S{{c ? 0 : (it & 1), c ? it - e3 : (it >> 1)}}; EpiFour E{Y, ML, 256, 1.f / 128.f, c ? 1 : 0};
            if (EN_F) pg8::gemm_phase<EpiFour, OneUnit, true, true>(lds, g, S, E, tid);
        } else if (it < e1) { const int j = it - e0; if (EN_D) diff_item(A, l, j >> 6, (j >> 4) & 3, j & 15, lds, tid); }
        else if (it < e2) { const int j = it - e1; if (EN_N) na_item_lat(A, l, j >> 6, (j >> 4) & 3, j & 15, lds, rpb_s, tid); }
        else if (it < e3) { if (EN_S) sgu_item(A, l, it - e2, lds, tid); }
        else if (it < e5) { const int j = it - e4; if (EN_D) diff_item(A, l, j >> 2, j & 3, -1, lds, tid); }
        else if (it < e6) { const int j = it - e5; if (EN_N) na_item(A, l, j >> 2, j & 3, -1, lds, rpb_s, tid); }
        else transpose_tile(A, l + 1, it - e6, lds, tid);
    }
}

constexpr int N_PHASES = 2 + 7 * DEPTH;
__global__ void __launch_bounds__(512, 2) mk_fwd(Args A) {
    extern __shared__ __attribute__((aligned(16))) unsigned char lds_raw[];
    LAS unsigned char* lds = (LAS unsigned char*)lds_raw;
    unsigned char* ws = A.ws;
    float* cx = (float*)(ws + WS_CX);
    const float* MOD = (const float*)(ws + WS_MOD);
    volatile LAS unsigned* bst = (volatile LAS unsigned*)(lds + MISC_OFF + 16);
    if (threadIdx.x == 0) { bst[0] = 0u; bst[1] = 0u; }
    __syncthreads();
    const XcdBarrier bar = xcd_barrier_post((unsigned*)(ws + WS_CTL) + 1024, bst);
    for (int ph = A.ph_lo; ph < A.ph_hi; ++ph) {
        if (ph > A.ph_lo) { if (A.ph_lo < 0) cg::this_grid().sync(); else xcd_barrier(bar); }
        int tid = threadIdx.x; asm volatile("" : "+v"(tid));
        if (ph == 0) { if (EN_P) phase_prologue(A, lds, tid);
#if PROBE_P0
            xcd_barrier(bar); tid = threadIdx.x; asm volatile("" : "+v"(tid)); phase_prologue(A, lds, tid, PROBE_P0);
#endif
            continue; }
        if (ph == N_PHASES - 1) {
#if PROBE_SYNC
            for (int q = 0; q < 32; ++q) xcd_barrier(bar);
#endif
            phase_final(A, tid); continue; }
        const int l = (ph - 1) / 7, s = (ph - 1) % 7; const bool last = l == DEPTH - 1;
        const float* xl = l == 0 ? A.in[0] : A.out;
        const int Mrows = last ? ML : MT;
        const float* mod = MOD + (size_t)l * 9 * 6144;
#if PROBE_S >= 0
        for (int rep = 0; rep < ((s == PROBE_S) ? 2 : 1); ++rep) {
        if (rep) { xcd_barrier(bar); tid = threadIdx.x; asm volatile("" : "+v"(tid)); }
#else
        { const int rep = 0;
#endif
        if (s == 0) phase_norm(A, l, 0, MT, xl, cx, l > 0 ? MOD + (size_t)((l - 1) * 9 + 8) * 6144 + 5 * 1024 : nullptr, tid);
        else if (s == 1) {
            LAS float* rope = (LAS float*)(lds + ROPE_OFF);
            { const int i = tid, pos = i >> 3, f = i & 7; const float ang = (float)pos * exp2f(-(float)f * (13.287712379549449f / 8.f));
              float t = ang * 0.15915494309189535f; t -= floorf(t); rope[2 * i] = __builtin_amdgcn_cosf(t); rope[2 * i + 1] = __builtin_amdgcn_sinf(t); }
            __syncthreads();
            pg8::Gemm g{(const bf16_t*)(ws + WS_H), (const bf16_t*)(ws + WS_WIN) + (size_t)l * NIN * 1024, MT, NIN, 1024};
            pg8::StaticOrder S; S.init(MT, NIN, gridDim.x, blockIdx.x); EpiIn E{ws, rope};
            if (EN_I) pg8::gemm_phase<EpiIn, pg8::StaticOrder, true, true>(lds, g, S, E, tid);
        } else if (s == 2) phase_mix(A, l, lds, rep);
        else if (s == 3 || s == 6) {
            const bool o = s == 3;
            const bf16_t* Aop = (const bf16_t*)(ws + (o ? WS_H : WS_U));
            const bf16_t* Bop = o ? (const bf16_t*)(ws + WS_WOUT) + (size_t)l * 1024 * 1024 : (const bf16_t*)(ws + WS_WFF2) + (size_t)l * 1024 * 4096;
            const int Kf = o ? 1024 : 4096;
            if (!last) {
                const int ksh = o ? 9 : 11;
                pg8::Gemm g2{Aop, Bop, MT, 1024, Kf / 4, Kf};
                SplitOrder S2{ksh, (int)gridDim.x, (int)blockIdx.x}; EpiPartial E2{(float*)(ws + WS_PB), ksh};
                pg8::gemm_phase<EpiPartial, SplitOrder, true, true>(lds, g2, S2, E2, tid);
                tid = threadIdx.x; asm volatile("" : "+v"(tid));
            }
            pg8::Gemm g{Aop, Bop, ML, 1024, Kf, Kf};
            pg8::StaticOrder S; S.init(ML, 1024, gridDim.x, blockIdx.x); EpiRes E{o ? xl : A.out, cx, A.out, cx, mod + (o ? 2 : 5) * 1024};
            if (EN_R) pg8::gemm_phase<EpiRes, pg8::StaticOrder, true, true>(lds, g, S, E, tid);
        } else if (s == 4) phase_norm(A, l, 1, Mrows, A.out, cx, mod + 8 * 6144 + 2 * 1024, tid);
        else if (s == 5) {
            pg8::Gemm g{(const bf16_t*)(ws + WS_H), (const bf16_t*)(ws + WS_WFF1) + (size_t)l * 4096 * 1024, Mrows, 4096, 1024};
            pg8::StaticOrder S; S.init(Mrows, 4096, gridDim.x, blockIdx.x); EpiFF1 E{(bf16_t*)(ws + WS_U)};
            if (EN_1) pg8::gemm_phase<EpiFF1, pg8::StaticOrder, true, true>(lds, g, S, E, tid);
        }
        }
    }
}

extern "C" void kernel_launch(void* const* d_in, const int* in_sizes, int n_in, void* d_out, int out_size, void* d_ws, size_t ws_size, hipStream_t stream) {
    static int grid = 0;
    if (grid == 0) {
        if (n_in != 23 || in_sizes[0] != ML * DM || out_size != ML * DM || ws_size < WS_END) {
            fprintf(stderr, "kernel_launch: unexpected shapes: n_in %d in0 %d out %d ws %zu (need %zu)\n", n_in, n_in > 0 ? in_sizes[0] : -1, out_size, ws_size, (size_t)WS_END); grid = -1; return; }
        int dev = 0, cus = 0, per_cu = 0;
        (void)hipGetDevice(&dev); (void)hipDeviceGetAttribute(&cus, hipDeviceAttributeMultiprocessorCount, dev);
        if (hipFuncSetAttribute((const void*)mk_fwd, hipFuncAttributeMaxDynamicSharedMemorySize, LDS_BYTES) != hipSuccess) { fprintf(stderr, "kernel_launch: hipFuncSetAttribute failed\n"); grid = -1; return; }
        if (hipOccupancyMaxActiveBlocksPerMultiprocessor(&per_cu, (const void*)mk_fwd, 512, LDS_BYTES) != hipSuccess || per_cu < 1) { fprintf(stderr, "kernel_launch: occupancy query gave %d\n", per_cu); per_cu = 1; }
        (void)hipGetLastError();
        grid = cus * per_cu;
    }
    if (grid < 0) return;
    (void)hipMemsetAsync((char*)d_ws + WS_CTL, 0, 32768, stream);
    Args a{};
    for (int i = 0; i < 23; ++i) a.in[i] = (const float*)d_in[i];
    a.out = (float*)d_out; a.ws = (unsigned char*)d_ws;
#if ONE_LAUNCH
    a.ph_lo = 0; a.ph_hi = N_PHASES;
    void* args[] = {&a};
    hipError_t e = hipLaunchCooperativeKernel((const void*)mk_fwd, dim3(grid), dim3(512), args, LDS_BYTES, stream);
    if (e != hipSuccess) fprintf(stderr, "kernel_launch: cooperative launch failed: %s (grid %d)\n", hipGetErrorString(e), grid);
#else
    for (int ph = 0; ph < N_PHASES; ++ph) { a.ph_lo = ph; a.ph_hi = ph + 1; hipLaunchKernelGGL(mk_fwd, dim3(grid), dim3(512), LDS_BYTES, stream, a); }
#endif
}
```

```cpp
#include <hip/hip_runtime.h>
#include <hip/hip_cooperative_groups.h>
#include <cstdio>
#include <cstdint>
namespace cg = cooperative_groups;
#ifndef ONE_LAUNCH
#define ONE_LAUNCH 1
#endif
#ifndef EN_F
#define EN_F 1
#endif
#ifndef EN_D
#define EN_D 1
#endif
#ifndef EN_N
#define EN_N 1
#endif
#ifndef EN_S
#define EN_S 1
#endif
#ifndef EN_P
#define EN_P 1
#endif
#ifndef EN_I
#define EN_I 1
#endif
#ifndef EN_R
#define EN_R 1
#endif
#ifndef EN_1
#define EN_1 1
#endif
#ifndef PROBE_S
#define PROBE_S -1
#endif
#ifndef PROBE_KIND
#define PROBE_KIND -1
#endif
#ifndef PROBE_P0
#define PROBE_P0 0
#endif
#ifndef PROBE_SYNC
#define PROBE_SYNC 0
#endif
namespace pg8 {
#define PG8_LAS __attribute__((address_space(3)))
typedef unsigned short bf16_t;
typedef short bf16x8 __attribute__((ext_vector_type(8)));
typedef float f32x4 __attribute__((ext_vector_type(4)));
typedef unsigned u32x4 __attribute__((ext_vector_type(4)));
constexpr int BM = 256, BK = 64, HALF = 128, HTB = HALF * BK * 2  , STAGE_BYTES = 8 * HTB, NXCD = 8, WGM = 8;

__host__ __device__ __forceinline__ int lds_byte(int r, int c) { const int st = (r >> 4) * 2 + (c >> 5), rr = r & 15, cc = c & 31, ob = rr * 64 + cc * 2; return st * 1024 + (ob ^ (((ob >> 9) & 1) << 5)); }
__host__ __device__ __forceinline__ void stage_rc(int b, int& R, int& C) { const int st = b / 1024, sb = b % 1024, swz = sb ^ (((sb >> 9) & 1) << 5); R = (st >> 1) * 16 + swz / 64; C = (st & 1) * 32 + (swz % 64) / 2; }
__host__ __device__ __forceinline__ int perm32(int rho) { const int n = rho >> 4, i = rho & 15; return 8 * (i >> 2) + 4 * n + (i & 3); }

struct Unit { int pm, pn, ko; };
struct Gemm { const bf16_t* A; const bf16_t* Bt; int M, N, K, ld; };

struct StaticOrder {
    int nM, nN, nwg, G, c;
    __host__ __device__ void init(int M, int N, int G_, int c_) { nM = M / BM; nN = N / BM; nwg = nM * nN; G = G_; c = c_; }
    __host__ __device__ bool next(int i, Unit& u) const {
        const long L = (long)i * G + c; if (L >= nwg) return false;
        int wgid = (int)L; { const int q = nwg / NXCD, r = nwg % NXCD, xcd = wgid % NXCD, off = wgid / NXCD; wgid = (xcd < r ? xcd * (q + 1) : r * (q + 1) + (xcd - r) * q) + off; }
        const int nig = WGM * nN, gid = wgid / nig, fm = gid * WGM, gsz = (nM - fm) < WGM ? (nM - fm) : WGM;
        u.pm = fm + ((wgid % nig) % gsz); u.pn = (wgid % nig) / gsz; u.ko = 0; return true;
    }
    __device__ __forceinline__ void a_ready(const Unit&) const {}
    __device__ __forceinline__ void done(const Unit&) const {}
};

template <class Epi, class Sched, bool ALIGN_EPI = false, bool SP2 = false>
__device__ __forceinline__ void gemm_phase(PG8_LAS unsigned char* lds, const Gemm g, const Sched& S, const Epi& E, const int tid) {
    const int wid = __builtin_amdgcn_readfirstlane(tid >> 6), lane = tid & 63, wr = wid >> 2, wc = wid & 3, fr = lane & 15, fq = lane >> 4;
    const int K = g.ld ? g.ld : g.K, nt = g.K / BK;
    unsigned voffA[2], voffB[2];
#pragma unroll
    for (int i = 0; i < 2; ++i) { int R, C; stage_rc(tid * 16 + i * 8192, R, C); const int Rb = Epi::PERM ? ((R & ~31) + perm32(R & 31)) : R;
        voffA[i] = (unsigned)(R * K + C) * 2u; voffB[i] = (unsigned)(Rb * K + C) * 2u; }
    const size_t kstep = (size_t)(BK * 2);
    const size_t hstep = (size_t)HALF * K * 2;
    const size_t tstep = 2 * hstep;
    const unsigned ldsw = (unsigned)wid * 1024u;
    const int aoff = lds_byte(wr * 64 + fr, fq * 8), boff = lds_byte(wc * 32 + fr, fq * 8);
#define PG8_SA(b, h) (((b) * 2 + (h)) * HTB)
#define PG8_SB(b, h) ((4 + (b) * 2 + (h)) * HTB)
#define PG8_STAGE(bufoff, gbase, voff) do { _Pragma("unroll") for (int _i = 0; _i < 2; ++_i) \
        __builtin_amdgcn_global_load_lds((const unsigned*)((const char*)(gbase) + (voff)[_i]), (PG8_LAS unsigned*)(lds + (bufoff) + ldsw + _i * 8192), 16, 0, 0); } while (0)
#define PG8_LDA(dst, b, h) do { _Pragma("unroll") for (int m = 0; m < 4; ++m) _Pragma("unroll") for (int k = 0; k < 2; ++k) dst[m][k] = *(const PG8_LAS bf16x8*)(lds + PG8_SA(b, h) + aoff + m * 2048 + k * 1024); } while (0)
#define PG8_LDB(dst, b, h) do { _Pragma("unroll") for (int n = 0; n < 2; ++n) _Pragma("unroll") for (int k = 0; k < 2; ++k) dst[n][k] = *(const PG8_LAS bf16x8*)(lds + PG8_SB(b, h) + boff + n * 2048 + k * 1024); } while (0)
#define PG8_MMA(ai, bj, At, Bt) do { __builtin_amdgcn_s_setprio(1); _Pragma("unroll") for (int m = 0; m < 4; ++m) _Pragma("unroll") for (int n = 0; n < 2; ++n) _Pragma("unroll") for (int k = 0; k < 2; ++k) \
        acc[ai][bj][m][n] = __builtin_amdgcn_mfma_f32_16x16x32_bf16(Bt[n][k], At[m][k], acc[ai][bj][m][n], 0, 0, 0); __builtin_amdgcn_s_setprio(0); } while (0)
#define PG8_WAIT_V(n) asm volatile("s_waitcnt vmcnt(" #n ")" ::: "memory")
#define PG8_WAIT_L(n) asm volatile("s_waitcnt lgkmcnt(" #n ")" ::: "memory")
#define PG8_BAR __builtin_amdgcn_s_barrier()
#define PG8_SCHED __builtin_amdgcn_sched_barrier(0)
    Unit cur, nxt; int ui = 0;
    if (!S.next(0, cur)) return;
    f32x4 acc[2][2][4][2];
#pragma unroll
    for (int a = 0; a < 2; ++a)
#pragma unroll
        for (int b = 0; b < 2; ++b)
#pragma unroll
            for (int m = 0; m < 4; ++m)
#pragma unroll
                for (int n = 0; n < 2; ++n) acc[a][b][m][n] = (f32x4){0.f, 0.f, 0.f, 0.f};
    bf16x8 At[4][2], B0[2][2], B1[2][2];
    const char* cA = (const char*)g.A + (size_t)cur.pm * tstep + cur.ko; const char* cB = (const char*)g.Bt + (size_t)cur.pn * tstep + cur.ko;
    S.a_ready(cur);
    if constexpr (SP2) {
        PG8_STAGE(PG8_SB(0, 0), cB, voffB); PG8_STAGE(PG8_SB(0, 1), cB + hstep, voffB); PG8_STAGE(PG8_SA(0, 0), cA, voffA); PG8_STAGE(PG8_SA(0, 1), cA + hstep, voffA);
        if (wr == 1) PG8_BAR;
        PG8_WAIT_V(2); PG8_BAR;
        PG8_STAGE(PG8_SB(1, 0), cB + kstep, voffB); PG8_STAGE(PG8_SA(1, 0), cA + kstep, voffA); PG8_STAGE(PG8_SB(1, 1), cB + hstep + kstep, voffB);
        PG8_WAIT_V(6); PG8_BAR;
    } else {
        PG8_STAGE(PG8_SB(0, 0), cB, voffB); PG8_STAGE(PG8_SA(0, 0), cA, voffA); PG8_STAGE(PG8_SB(0, 1), cB + hstep, voffB); PG8_STAGE(PG8_SA(0, 1), cA + hstep, voffA);
        if (wr == 1) PG8_BAR;
        PG8_WAIT_V(4); PG8_BAR;
        PG8_STAGE(PG8_SB(1, 0), cB + kstep, voffB); PG8_STAGE(PG8_SA(1, 0), cA + kstep, voffA); PG8_STAGE(PG8_SB(1, 1), cB + hstep + kstep, voffB);
        PG8_WAIT_V(6); PG8_BAR;
    }
    for (;;) {
        const bool has_next = S.next(ui + 1, nxt);
        const char* nA = has_next ? (const char*)g.A + (size_t)nxt.pm * tstep + nxt.ko : cA; const char* nB = has_next ? (const char*)g.Bt + (size_t)nxt.pn * tstep + nxt.ko : cB;
        for (int t = 0; t < nt; t += 2) {
            const bool last = (t == nt - 2);
            const char* a1 = cA + (size_t)(t + 1) * kstep;
            const char* a2 = last ? nA : cA + (size_t)(t + 2) * kstep; const char* b2 = last ? nB : cB + (size_t)(t + 2) * kstep;
            const char* a3 = a2 + kstep; const char* b3 = b2 + kstep;
            if (last && has_next) S.a_ready(nxt);
            if constexpr (SP2) {
            PG8_LDB(B0, 0, 0); PG8_LDB(B1, 0, 1); PG8_SCHED; PG8_LDA(At, 0, 0); PG8_STAGE(PG8_SA(1, 1), a1 + hstep, voffA);
            PG8_WAIT_V(8); PG8_WAIT_L(0); PG8_BAR; PG8_MMA(0, 0, At, B0); PG8_MMA(0, 1, At, B1); PG8_BAR; PG8_SCHED;
            PG8_LDA(At, 0, 1); PG8_STAGE(PG8_SB(0, 0), b2, voffB); PG8_STAGE(PG8_SB(0, 1), b2 + hstep, voffB); PG8_STAGE(PG8_SA(0, 0), a2, voffA);
            PG8_WAIT_V(8); PG8_WAIT_L(0); PG8_BAR; PG8_MMA(1, 0, At, B0); PG8_MMA(1, 1, At, B1); PG8_BAR; PG8_SCHED;
            PG8_LDB(B0, 1, 0); PG8_LDB(B1, 1, 1); PG8_SCHED; PG8_LDA(At, 1, 0); PG8_STAGE(PG8_SA(0, 1), a2 + hstep, voffA);
            PG8_WAIT_V(8); PG8_WAIT_L(0); PG8_BAR; PG8_MMA(0, 0, At, B0); PG8_MMA(0, 1, At, B1); PG8_BAR; PG8_SCHED;
            PG8_LDA(At, 1, 1); PG8_STAGE(PG8_SB(1, 0), b3, voffB); PG8_STAGE(PG8_SB(1, 1), b3 + hstep, voffB); PG8_STAGE(PG8_SA(1, 0), a3, voffA);
            PG8_WAIT_V(8); PG8_WAIT_L(0); PG8_BAR; PG8_MMA(1, 0, At, B0); PG8_MMA(1, 1, At, B1); PG8_BAR; PG8_SCHED;
            } else {
            PG8_LDB(B0, 0, 0); PG8_SCHED; PG8_LDA(At, 0, 0); PG8_STAGE(PG8_SA(1, 1), a1 + hstep, voffA);
            PG8_WAIT_L(8); PG8_BAR; PG8_WAIT_L(0); PG8_MMA(0, 0, At, B0); PG8_BAR; PG8_SCHED;
            PG8_LDB(B1, 0, 1); PG8_STAGE(PG8_SB(0, 0), b2, voffB);
            PG8_BAR; PG8_WAIT_L(0); PG8_MMA(0, 1, At, B1); PG8_BAR;
            PG8_LDA(At, 0, 1); PG8_STAGE(PG8_SA(0, 0), a2, voffA);
            PG8_BAR; PG8_WAIT_L(0); PG8_MMA(1, 0, At, B0); PG8_BAR; PG8_SCHED;
            PG8_STAGE(PG8_SB(0, 1), b2 + hstep, voffB);
            PG8_WAIT_V(6); PG8_BAR; PG8_MMA(1, 1, At, B1); PG8_BAR;
            PG8_LDB(B0, 1, 0); PG8_SCHED; PG8_LDA(At, 1, 0); PG8_STAGE(PG8_SA(0, 1), a2 + hstep, voffA);
            PG8_WAIT_L(8); PG8_BAR; PG8_WAIT_L(0); PG8_MMA(0, 0, At, B0); PG8_BAR; PG8_SCHED;
            PG8_LDB(B1, 1, 1); PG8_STAGE(PG8_SB(1, 0), b3, voffB);
            PG8_BAR; PG8_WAIT_L(0); PG8_MMA(0, 1, At, B1); PG8_BAR;
            PG8_LDA(At, 1, 1); PG8_STAGE(PG8_SA(1, 0), a3, voffA);
            PG8_BAR; PG8_WAIT_L(0); PG8_MMA(1, 0, At, B0); PG8_BAR; PG8_SCHED;
            PG8_STAGE(PG8_SB(1, 1), b3 + hstep, voffB);
            PG8_WAIT_V(6); PG8_BAR; PG8_MMA(1, 1, At, B1); PG8_BAR;
            }
        }
        if constexpr (ALIGN_EPI) { if (wr == 0) PG8_BAR; }
        if constexpr (!Epi::AFTER_DRAIN) { E(acc, cur, wr, wc, fr, fq); S.done(cur); }
        if (!has_next) break;
#pragma unroll
        for (int a = 0; a < 2; ++a)
#pragma unroll
            for (int b = 0; b < 2; ++b)
#pragma unroll
                for (int m = 0; m < 4; ++m)
#pragma unroll
                    for (int n = 0; n < 2; ++n) acc[a][b][m][n] = (f32x4){0.f, 0.f, 0.f, 0.f};
        cur = nxt; cA = nA; cB = nB; ++ui;
        if constexpr (ALIGN_EPI) { if (wr == 1) PG8_BAR; }
    }
    PG8_WAIT_V(0);
    if constexpr (!ALIGN_EPI) { if (wr == 0) PG8_BAR; }
    PG8_BAR;
    if constexpr (Epi::AFTER_DRAIN) { E.fused(acc, cur, wr, wc, fr, fq, lds, wid, lane); S.done(cur); }
#undef PG8_SA
#undef PG8_SB
#undef PG8_STAGE
#undef PG8_LDA
#undef PG8_LDB
#undef PG8_MMA
#undef PG8_WAIT_V
#undef PG8_WAIT_L
#undef PG8_BAR
#undef PG8_SCHED
}
}
#define DI __device__ __forceinline__
#define LAS __attribute__((address_space(3)))
typedef unsigned short bf16_t;
typedef short bf16x8 __attribute__((ext_vector_type(8)));
typedef short s16x4 __attribute__((ext_vector_type(4)));
typedef float f32x4 __attribute__((ext_vector_type(4)));
typedef float f32x2 __attribute__((ext_vector_type(2)));
typedef float f32x16 __attribute__((ext_vector_type(16)));
typedef unsigned u32x4 __attribute__((ext_vector_type(4)));
typedef unsigned u32x2 __attribute__((ext_vector_type(2)));
typedef __bf16 bf2_t __attribute__((ext_vector_type(2)));
DI unsigned pk2(float lo, float hi) { f32x2 v = {lo, hi}; return __builtin_bit_cast(unsigned, __builtin_convertvector(v, bf2_t)); }
DI bf16_t f2bf(float x) { return (bf16_t)(pk2(x, 0.f) & 0xffffu); }
DI float bf2f(unsigned v) { return __builtin_bit_cast(float, v << 16); }
#define MFMA32(a, b, c) __builtin_amdgcn_mfma_f32_32x32x16_bf16((a), (b), (c), 0, 0, 0)
DI float ex2(float x) { return __builtin_amdgcn_exp2f(x); }
DI float xor32(float v) { return __shfl_xor(v, 32); }

constexpr int DM = 1024, NB = 8, SEQ = 4096, DEPTH = 4, CTX = 256, DFF = 4096;
constexpr int ML = NB * SEQ, MC = NB * CTX, MT = ML + MC, NIN = 2560, KV = SEQ + CTX;
constexpr float LOG2E = 1.4426950408889634f;
constexpr size_t MiB = 1u << 20;
constexpr size_t WS_CTL = 0, WS_LAM = 32768, WS_MOD = 1 * MiB, WS_CSC = 2 * MiB, WS_WIN = 4 * MiB, WS_WOUT = 24 * MiB, WS_WFF1 = 32 * MiB,
                 WS_WFF2 = 64 * MiB, WS_CS = 96 * MiB, WS_H = 160 * MiB, WS_CX = 228 * MiB, WS_U = 236 * MiB;
constexpr size_t WS_PQT = WS_U, WS_PQTC = WS_U + 32 * MiB, WS_NAQ = WS_U + 34 * MiB, WS_NAK = WS_U + 51 * MiB, WS_SGU = WS_U + 68 * MiB,
                 WS_SGV = WS_U + 85 * MiB, WS_DFQ = WS_U + 102 * MiB, WS_DFK = WS_U + 119 * MiB, WS_NAVT = WS_U + 136 * MiB, WS_DFVT = WS_U + 153 * MiB;
constexpr size_t WS_END = WS_U + 272 * MiB;
constexpr size_t WS_SGW = 2 * MiB + 256 * 1024;
constexpr size_t WS_PB = WS_CS + 1 * MiB;
constexpr int LDS_BYTES = 147456, MISC_OFF = 131072, ROPE_OFF = MISC_OFF + 1024, RPB_OFF = MISC_OFF + 5120;

struct Args { const float* in[23]; float* out; unsigned char* ws; int ph_lo, ph_hi; };

DI void transpose_tile(const Args& A, int l, int r, LAS unsigned char* lds, const int tid) {
    const int lane = tid & 63, wid = __builtin_amdgcn_readfirstlane(tid >> 6);
    unsigned char* ws = A.ws;
    LAS float* big = (LAS float*)(lds + 53248);
    const float* src; bf16_t* dst; int K, N, kt, nt;
    if (r < 128) { K = 1024; N = 2304; kt = r >> 3; nt = r & 7; src = A.in[8] + (size_t)l * 1024 * 2304 + 256; dst = (bf16_t*)(ws + WS_WIN) + (size_t)l * NIN * 1024 + 512 * 1024; }
    else if (r < 192) { r -= 128; K = 1024; N = 1024; kt = r >> 2; nt = r & 3; src = A.in[9] + (size_t)l * 1024 * 1024; dst = (bf16_t*)(ws + WS_WOUT) + (size_t)l * 1024 * 1024; }
    else if (r < 448) { r -= 192; K = 1024; N = 4096; kt = r >> 4; nt = r & 15; src = A.in[20] + (size_t)l * 1024 * 4096; dst = (bf16_t*)(ws + WS_WFF1) + (size_t)l * 4096 * 1024; }
    else { r -= 448; K = 4096; N = 1024; kt = r >> 2; nt = r & 3; src = A.in[21] + (size_t)l * 4096 * 1024; dst = (bf16_t*)(ws + WS_WFF2) + (size_t)l * 1024 * 4096; }
    float v[32];
    const float* sp = src + (size_t)(kt * 64 + (tid >> 6)) * N + nt * 256 + lane;
#pragma unroll
    for (int i = 0; i < 8; ++i)
#pragma unroll
        for (int j = 0; j < 4; ++j) v[i * 4 + j] = __builtin_nontemporal_load(sp + (size_t)(8 * i) * N + 64 * j);
    __syncthreads();
#pragma unroll
    for (int i = 0; i < 8; ++i)
#pragma unroll
        for (int j = 0; j < 4; ++j) big[(wid + 8 * i) * 257 + 64 * j + lane] = v[i * 4 + j];
    __syncthreads();
#pragma unroll 4
    for (int i = 0; i < 32; ++i) { const int nn = wid + 8 * i; dst[(size_t)(nt * 256 + nn) * K + kt * 64 + lane] = f2bf(big[lane * 257 + nn]); }
}

DI void phase_prologue(const Args& A, LAS unsigned char* lds, const int tid, const int parts = 15) {
    const int lane = tid & 63, wid = __builtin_amdgcn_readfirstlane(tid >> 6);
    unsigned char* ws = A.ws;
    LAS float* silu_t = (LAS float*)lds;
    LAS float* cos_t = (LAS float*)(lds + 36864);
    LAS float* tile = (LAS float*)(lds + 53248);
    LAS float* red = (LAS float*)(lds + 69888);
    for (int i = tid; i < 9 * 1024; i += 512) { const int r = i >> 10, k = i & 1023; const float v = r < 8 ? A.in[1][r * 1024 + k] : A.in[3][k]; silu_t[i] = v / (1.f + expf(-v)); }
    for (int i = tid; i < 4096; i += 512) cos_t[i] = cospif((float)i * (1.f / 2048.f));
    LAS float* c64 = (LAS float*)(lds + 122880);
    if (tid < 64) { c64[tid] = cospif((float)tid * (1.f / 32.f)); c64[64 + tid] = sinpif((float)tid * (1.f / 32.f)); }
    if (blockIdx.x == 0 && tid < DEPTH) {
        const int l = tid; float s1 = 0.f, s2 = 0.f;
        for (int i = 0; i < 32; ++i) { s1 += A.in[15][l * 32 + i] * A.in[16][l * 32 + i]; s2 += A.in[17][l * 32 + i] * A.in[18][l * 32 + i]; }
        const float lam_init = 0.8f - 0.6f * expf(-0.3f * (float)l);
        float* lt = (float*)(ws + WS_LAM); lt[2 * l] = expf(s1) - expf(s2) + lam_init; lt[2 * l + 1] = 1.f - lam_init;
    }
    __syncthreads();
    {
        const float* src = A.in[13]; bf16_t* dst = (bf16_t*)(ws + WS_SGW);
        for (int i = blockIdx.x * 512 + tid; i < DEPTH * 4 * 128 * 128 / 2; i += gridDim.x * 512) ((unsigned*)dst)[i] = pk2(src[2 * i], src[2 * i + 1]);
    }
    {
        const f32x4* src = (const f32x4*)A.in[2]; f32x4* dst = (f32x4*)(ws + WS_CX);
        for (int i = blockIdx.x * 512 + tid; i < MC * DM / 4; i += gridDim.x * 512) dst[i] = src[i];
    }
    bf16_t* CS = (bf16_t*)(ws + WS_CS);
    if (parts & 1)
    for (int rr = blockIdx.x; rr < 512; rr += gridDim.x) {
        const int pm = rr >> 8, row = rr & 255, cs = row >> 7, k1 = 128 * pm + (row & 127), pq = tid >> 8, n1 = tid & 255;
        const int t = ((n1 * k1) & 255) * 16;
        const float cv = cos_t[t], sv = cos_t[(t + 3072) & 4095];
        CS[(size_t)rr * 512 + tid] = f2bf(cs == 0 ? (pq == 0 ? cv : sv) : (pq == 0 ? -sv : cv));
    }
    bf16_t* CSc = (bf16_t*)(ws + WS_CSC);
    for (int k = blockIdx.x; k < 256; k += gridDim.x) { const int j = tid, jj = j & 255; int t = ((k * jj) & 255) * 16; if (j >= 256) t = (t + 3072) & 4095; CSc[k * 512 + j] = f2bf(cos_t[t]); }
    if (parts & 2)
    for (int it = blockIdx.x; it < 256; it += gridDim.x) {
        const int l = it >> 6, h = (it >> 4) & 3, kb = it & 15;
        const float* src = A.in[8] + (size_t)l * 1024 * 2304 + (size_t)(kb * 64) * 2304 + h * 64;
        __syncthreads();
#pragma unroll
        for (int i = 0; i < 8; ++i) { const int kk = wid + 8 * i; tile[kk * 65 + lane] = src[(size_t)kk * 2304 + lane]; }
        __syncthreads();
        bf16_t* dst = (bf16_t*)(ws + WS_WIN) + (size_t)l * NIN * 1024;
        const int m = lane;
#pragma unroll 1
        for (int i = 0; i < 8; ++i) {
            const int kk = wid + 8 * i; float P = 0.f, Q = 0.f;
#pragma unroll 4
            for (int c = 0; c < 64; ++c) { const float w = tile[kk * 65 + c]; const int t = (c * m) & 63; P += w * c64[t]; Q += w * c64[64 + t]; }
            dst[(size_t)(h * 64 + m) * 1024 + kb * 64 + kk] = f2bf(P); dst[(size_t)(256 + h * 64 + m) * 1024 + kb * 64 + kk] = f2bf(-Q);
        }
    }
    if (parts & 4)
    for (int it = blockIdx.x; it < 704; it += gridDim.x) transpose_tile(A, 0, it, lds, tid);
    float* MOD = (float*)(ws + WS_MOD);
    if (parts & 8)
    for (int it = blockIdx.x; it < 4 * 192; it += gridDim.x) {
        const int l = it / 192, nb = it % 192, cl = lane & 31, kp = lane >> 5;
        const float* w = A.in[4] + (size_t)l * 1024 * 6144 + nb * 32 + cl;
        float acc[9];
#pragma unroll
        for (int r = 0; r < 9; ++r) acc[r] = 0.f;
#pragma unroll 16
        for (int k = wid * 128 + kp; k < wid * 128 + 128; k += 2) {
            const float wv = __builtin_nontemporal_load(w + (size_t)k * 6144);
#pragma unroll
            for (int r = 0; r < 9; ++r) acc[r] += silu_t[r * 1024 + k] * wv;
        }
        __syncthreads();
#pragma unroll
        for (int r = 0; r < 9; ++r) red[(wid * 9 + r) * 64 + lane] = acc[r];
        __syncthreads();
        for (int i = tid; i < 9 * 32; i += 512) {
            const int r = i >> 5, nn = i & 31; float sm = 0.f;
            for (int w8 = 0; w8 < 8; ++w8) sm += red[(w8 * 9 + r) * 64 + nn] + red[(w8 * 9 + r) * 64 + 32 + nn];
            MOD[(size_t)(l * 9 + r) * 6144 + nb * 32 + nn] = sm + A.in[5][l * 6144 + nb * 32 + nn];
        }
    }
}

DI float wave_sum(float v) {
#pragma unroll
    for (int o = 32; o > 0; o >>= 1) v += __shfl_xor(v, o);
    return v;
}
DI void phase_norm(const Args& A, int l, int which, int nrows, const float* srcL, float* srcC, const float* pgate, const int tid) {
    const int lane = tid & 63, wid = tid >> 6;
    const float* g = A.in[which ? 7 : 6] + l * 1024;
    const float* mod = (const float*)(A.ws + WS_MOD) + (size_t)l * 9 * 6144;
    bf16_t* H = (bf16_t*)(A.ws + WS_H);
    const int stride = gridDim.x * 8;
    constexpr int NR = 4;
    for (int row0 = blockIdx.x * 8 + wid; row0 < nrows; row0 += NR * stride) {
        f32x4 v[NR][4]; float ss[NR];
#pragma unroll
        for (int u = 0; u < NR; ++u) {
            const int row = min(row0 + u * stride, nrows - 1);
            const float* src = row < ML ? srcL + (size_t)row * 1024 : srcC + (size_t)(row - ML) * 1024;
            ss[u] = 0.f;
#pragma unroll
            for (int i = 0; i < 4; ++i) v[u][i] = __builtin_nontemporal_load((const f32x4*)(src + i * 256 + lane * 4));
            if (pgate != nullptr && row >= ML) {
                const float* pb = (const float*)(A.ws + WS_PB) + (size_t)(row - ML) * 1024;
#pragma unroll
                for (int i = 0; i < 4; ++i) {
                    const int k = i * 256 + lane * 4;
                    const f32x4 p = *(const f32x4*)(pb + k) + *(const f32x4*)(pb + (size_t)MC * 1024 + k) + *(const f32x4*)(pb + (size_t)2 * MC * 1024 + k) + *(const f32x4*)(pb + (size_t)3 * MC * 1024 + k);
                    v[u][i] = v[u][i] + *(const f32x4*)(pgate + k) * p;
                    if (row0 + u * stride < nrows) *(f32x4*)(srcC + (size_t)(row - ML) * 1024 + k) = v[u][i];
                }
            }
#pragma unroll
            for (int i = 0; i < 4; ++i) ss[u] += v[u][i].x * v[u][i].x + v[u][i].y * v[u][i].y + v[u][i].z * v[u][i].z + v[u][i].w * v[u][i].w;
        }
#pragma unroll
        for (int u = 0; u < NR; ++u) {
            const int row = row0 + u * stride;
            if (row < nrows) {
                const int bidx = row < ML ? (row >> 12) : 8;
                const float* sh = mod + bidx * 6144 + (which ? 3 : 0) * 1024; const float* sc = sh + 1024;
                const float r = rsqrtf(wave_sum(ss[u]) * (1.f / 1024.f) + 1e-6f);
#pragma unroll
                for (int i = 0; i < 4; ++i) {
                    const int k = i * 256 + lane * 4;
                    const f32x4 gv = *(const f32x4*)(g + k), sv = *(const f32x4*)(sc + k), hv = *(const f32x4*)(sh + k);
                    const f32x4 y = v[u][i] * r * gv * (1.f + sv) + hv;
                    u32x2 o; o.x = pk2(y.x, y.y); o.y = pk2(y.z, y.w);
                    *(u32x2*)(H + (size_t)row * 1024 + k) = o;
                }
            }
        }
    }
}
DI void phase_final(const Args& A, const int tid) {
    const int lane = tid & 63, wid = tid >> 6;
    const float* g = A.in[22];
    for (int row = blockIdx.x * 8 + wid; row < ML; row += gridDim.x * 8) {
        float* p = A.out + (size_t)row * 1024;
        f32x4 v[4]; float ss = 0.f;
#pragma unroll
        for (int i = 0; i < 4; ++i) { v[i] = __builtin_nontemporal_load((const f32x4*)(p + i * 256 + lane * 4)); ss += v[i].x * v[i].x + v[i].y * v[i].y + v[i].z * v[i].z + v[i].w * v[i].w; }
        ss = wave_sum(ss);
        const float r = rsqrtf(ss * (1.f / 1024.f) + 1e-6f);
#pragma unroll
        for (int i = 0; i < 4; ++i) { const int k = i * 256 + lane * 4; __builtin_nontemporal_store(v[i] * r * *(const f32x4*)(g + k), (f32x4*)(p + k)); }
    }
}
struct OneUnit {
    pg8::Unit u;
    DI bool next(int i, pg8::Unit& o) const { if (i) return false; o = u; return true; }
    DI void a_ready(const pg8::Unit&) const {}
    DI void done(const pg8::Unit&) const {}
};
DI float gelu_tanh(float x) { const float y = 0.7978845608028654f * (x + 0.044715f * x * x * x); return x * __builtin_amdgcn_rcpf(1.f + ex2(-2.f * LOG2E * y)); }

struct EpiIn {
    static constexpr bool PERM = true, AFTER_DRAIN = false;
    unsigned char* ws; const LAS float* rope;
    DI void operator()(const pg8::f32x4 (&acc)[2][2][4][2], const pg8::Unit& u, int wr, int wc, int fr, int fq) const {
        const int pm = u.pm, pn = u.pn; const bool lat = pm < 128; const int b = lat ? (pm >> 4) : (pm - 128);
        const int r0 = pm * 256 + wr * 64 + fr, c0 = wc * 32 + 8 * fq;
        const int p0 = lat ? (r0 & 4095) : (r0 - ML - b * 256);
        if (pn <= 1 || pn == 4 || pn == 9) {
            bf16_t* base; unsigned rs; int poff;
            if (pn <= 1 && lat) {
                bf16_t* zt = (bf16_t*)(ws + WS_PQT);
                const int n2 = fr, n1b = (pm & 15) * 16 + wr * 4;
#pragma unroll
                for (int ai = 0; ai < 2; ++ai)
#pragma unroll
                    for (int bj = 0; bj < 2; ++bj) {
                        const int hmhi = 2 * wc + 8 * bj + (fq >> 1);
#pragma unroll
                        for (int e = 0; e < 8; ++e) {
                            const int hmlo = 8 * (fq & 1) + e;
                            const int c = 128 * (n2 >> 3) + 4 * ((n2 >> 2) & 1) + (n2 & 3) + 32 * (hmlo >> 2) + 8 * (hmlo & 3);
                            u32x2 w;
                            w.x = pk2(acc[ai][bj][0][e >> 2][e & 3], acc[ai][bj][1][e >> 2][e & 3]); w.y = pk2(acc[ai][bj][2][e >> 2][e & 3], acc[ai][bj][3][e >> 2][e & 3]);
                            *(u32x2*)(zt + ((unsigned)((b * 16 + hmhi) * 256 + c) * 512u + (unsigned)(pn * 256 + n1b + 8 * ai))) = w;
                        }
                        __builtin_amdgcn_sched_barrier(0);
                    }
                return;
            }
            if (pn <= 1) { base = (bf16_t*)(ws + WS_PQTC) + (size_t)b * 256 * 512; rs = 512; poff = 256 * pn; }
            else { base = (bf16_t*)(ws + (pn == 4 ? WS_NAVT : WS_DFVT)) + (size_t)b * 256 * KV; rs = KV; poff = lat ? 0 : 4096; }
#pragma unroll
            for (int ai = 0; ai < 2; ++ai)
#pragma unroll
                for (int m = 0; m < 4; ++m) {
                    const int pos = p0 + 128 * ai + 16 * m + poff;
#pragma unroll
                    for (int bj = 0; bj < 2; ++bj) {
                        const unsigned d = (unsigned)(c0 + 128 * bj) * rs + (unsigned)pos;
#pragma unroll
                        for (int e = 0; e < 8; ++e) base[d + (unsigned)e * rs] = f2bf(acc[ai][bj][m][e >> 2][e & 3]);
                    }
                    __builtin_amdgcn_sched_barrier(0);
                }
        } else {
            bf16_t* O; float sc = 1.f; int mode = 0;
            if (pn == 2) { O = (bf16_t*)(ws + WS_NAQ); sc = 0.125f * LOG2E; }
            else if (pn == 3) { O = (bf16_t*)(ws + WS_NAK); }
            else if (pn == 5) { O = (bf16_t*)(ws + WS_SGU); mode = 1; }
            else if (pn == 6) { O = (bf16_t*)(ws + WS_SGV); mode = 1; }
            else if (pn == 7) { O = (bf16_t*)(ws + WS_DFQ); sc = 0.17677669529663687f * LOG2E; mode = lat ? 2 : 0; }
            else { O = (bf16_t*)(ws + WS_DFK); mode = lat ? 2 : 0; }
#pragma unroll
            for (int ai = 0; ai < 2; ++ai)
#pragma unroll
                for (int m = 0; m < 4; ++m) {
                    const int row = r0 + 128 * ai + 16 * m, pos = p0 + 128 * ai + 16 * m;
#pragma unroll
                    for (int bj = 0; bj < 2; ++bj) {
                        float v[8];
#pragma unroll
                        for (int e = 0; e < 8; ++e) v[e] = acc[ai][bj][m][e >> 2][e & 3];
                        if (mode == 1) {
#pragma unroll
                            for (int e = 0; e < 8; ++e) v[e] = gelu_tanh(v[e]);
                        } else if (mode == 2) {
                            const int pa = (fq < 2) ? (pos >> 6) : (pos & 63);
                            const LAS float* tab = rope + pa * 16;
#pragma unroll
                            for (int e = 0; e < 8; ++e) {
                                const float pr = __shfl_xor(v[e], 16), cs = tab[2 * e], sn = tab[2 * e + 1];
                                v[e] = v[e] * cs + ((fq & 1) ? pr * sn : -pr * sn);
                            }
                        }
                        u32x4 w; w.x = pk2(v[0] * sc, v[1] * sc); w.y = pk2(v[2] * sc, v[3] * sc); w.z = pk2(v[4] * sc, v[5] * sc); w.w = pk2(v[6] * sc, v[7] * sc);
                        *(u32x4*)(O + ((unsigned)row * 256u + (unsigned)(c0 + 128 * bj))) = w;
                        __builtin_amdgcn_sched_barrier(0);
                    }
                }
        }
    }
};
struct EpiRes {
    static constexpr bool PERM = false, AFTER_DRAIN = false;
    const float* srcL; const float* srcC; float* dstL; float* dstC; const float* gate;
    DI void operator()(const pg8::f32x4 (&acc)[2][2][4][2], const pg8::Unit& u, int wr, int wc, int fr, int fq) const {
        const int pm = u.pm; const bool lat = pm < 128; const float* g = gate + (lat ? (pm >> 4) : 8) * 6144;
        const int row0 = pm * 256 + wr * 64 + fr, col0 = u.pn * 256 + wc * 32 + 4 * fq;
#pragma unroll
        for (int ai = 0; ai < 2; ++ai)
#pragma unroll
            for (int m = 0; m < 4; ++m) {
                const int row = row0 + 128 * ai + 16 * m;
                const float* s = lat ? srcL : srcC; float* d = lat ? dstL : dstC;
                const unsigned ro = (unsigned)(lat ? row : row - ML) * 1024u;
#pragma unroll
                for (int bj = 0; bj < 2; ++bj)
#pragma unroll
                    for (int n = 0; n < 2; ++n) {
                        const unsigned col = (unsigned)(col0 + 128 * bj + 16 * n);
                        const f32x4 xv = *(const f32x4*)(s + (ro + col)), gv = *(const f32x4*)(g + col);
                        *(f32x4*)(d + (ro + col)) = xv + gv * acc[ai][bj][m][n];
                    }
            }
    }
};
struct SplitOrder {
    int kshift, G, c;
    DI bool next(int i, pg8::Unit& u) const { const int p = i * G + c; if (p >= 128) return false; u.pm = 128 + (p >> 4); u.pn = (p >> 2) & 3; u.ko = (p & 3) << kshift; return true; }
    DI void a_ready(const pg8::Unit&) const {}
    DI void done(const pg8::Unit&) const {}
};
struct EpiPartial {
    static constexpr bool PERM = false, AFTER_DRAIN = false;
    float* PB; int kshift;
    DI void operator()(const pg8::f32x4 (&acc)[2][2][4][2], const pg8::Unit& u, int wr, int wc, int fr, int fq) const {
        float* base = PB + (size_t)(u.ko >> kshift) * MC * 1024;
        const int row0 = (u.pm - 128) * 256 + wr * 64 + fr, col0 = u.pn * 256 + wc * 32 + 4 * fq;
#pragma unroll
        for (int ai = 0; ai < 2; ++ai)
#pragma unroll
            for (int m = 0; m < 4; ++m)
#pragma unroll
                for (int bj = 0; bj < 2; ++bj)
#pragma unroll
                    for (int n = 0; n < 2; ++n)
                        *(f32x4*)(base + ((unsigned)(row0 + 128 * ai + 16 * m) * 1024u + (unsigned)(col0 + 128 * bj + 16 * n))) = acc[ai][bj][m][n];
    }
};
struct EpiFF1 {
    static constexpr bool PERM = true, AFTER_DRAIN = false;
    bf16_t* U;
    DI void operator()(const pg8::f32x4 (&acc)[2][2][4][2], const pg8::Unit& u, int wr, int wc, int fr, int fq) const {
        const int row0 = u.pm * 256 + wr * 64 + fr, col0 = u.pn * 256 + wc * 32 + 8 * fq;
#pragma unroll
        for (int ai = 0; ai < 2; ++ai)
#pragma unroll
            for (int m = 0; m < 4; ++m)
#pragma unroll
                for (int bj = 0; bj < 2; ++bj) {
                    f32x4 a0 = acc[ai][bj][m][0], a1 = acc[ai][bj][m][1];
                    a0 = __builtin_elementwise_max(a0, (f32x4){0.f, 0.f, 0.f, 0.f}); a1 = __builtin_elementwise_max(a1, (f32x4){0.f, 0.f, 0.f, 0.f});
                    a0 = a0 * a0; a1 = a1 * a1;
                    u32x4 w; w.x = pk2(a0[0], a0[1]); w.y = pk2(a0[2], a0[3]); w.z = pk2(a1[0], a1[1]); w.w = pk2(a1[2], a1[3]);
                    *(u32x4*)(U + ((unsigned)(row0 + 128 * ai + 16 * m) * 4096u + (unsigned)(col0 + 128 * bj))) = w;
                }
    }
};
constexpr float C16[16] = {1.f, 0.92387953251f, 0.70710678119f, 0.38268343237f, 0.f, -0.38268343237f, -0.70710678119f, -0.92387953251f,
                           -1.f, -0.92387953251f, -0.70710678119f, -0.38268343237f, 0.f, 0.38268343237f, 0.70710678119f, 0.92387953251f};
constexpr float S16[16] = {0.f, 0.38268343237f, 0.70710678119f, 0.92387953251f, 1.f, 0.92387953251f, 0.70710678119f, 0.38268343237f,
                           0.f, -0.38268343237f, -0.70710678119f, -0.92387953251f, -1.f, -0.92387953251f, -0.70710678119f, -0.38268343237f};
struct EpiFour {
    static constexpr bool PERM = true, AFTER_DRAIN = false;
    bf16_t* Y; int rowbase, rpb; float scale; int kind;
    DI void operator()(const pg8::f32x4 (&acc)[2][2][4][2], const pg8::Unit& u, int wr, int wc, int fr, int fq) const {
        if (kind == 0) {
            const int b = u.pn >> 4, hm = 16 * (u.pn & 15) + 4 * wc + fq;
#pragma unroll
            for (int m = 0; m < 4; ++m) {
                const int k1 = 128 * u.pm + 64 * wr + 16 * m + fr;
                float zr[16], zi[16];
#pragma unroll
                for (int n2 = 0; n2 < 16; ++n2) {
                    const float tc = acc[0][n2 >> 3][m][(n2 >> 2) & 1][n2 & 3], ts = acc[1][n2 >> 3][m][(n2 >> 2) & 1][n2 & 3];
                    const float fr_ = (float)((n2 * k1) & 4095) * (1.f / 4096.f);
                    const float c = __builtin_amdgcn_cosf(fr_), sn = __builtin_amdgcn_sinf(fr_);
                    zr[n2] = tc * c + ts * sn; zi[n2] = tc * sn - ts * c;
                }
                bf16_t* yp = Y + ((unsigned)(b * 4096 + k1) * 1024u + (unsigned)hm);
#pragma unroll
                for (int k2 = 0; k2 < 16; ++k2) {
                    float o = 0.f;
#pragma unroll
                    for (int n2 = 0; n2 < 16; ++n2) {
                        const float cc = C16[(n2 * k2) & 15], sc = S16[(n2 * k2) & 15];
                        if (cc != 0.f) o += zr[n2] * cc;
                        if (sc != 0.f) o -= zi[n2] * sc;
                    }
                    yp[(unsigned)k2 * 256u * 1024u] = f2bf(o * (1.f / 512.f));
                }
                __builtin_amdgcn_sched_barrier(0);
            }
            return;
        }
        const int row0 = rowbase + u.pn * rpb + u.pm * 256 + wr * 64 + fr, col0 = wc * 32 + 8 * fq;
#pragma unroll
        for (int ai = 0; ai < 2; ++ai)
#pragma unroll
            for (int m = 0; m < 4; ++m)
#pragma unroll
                for (int bj = 0; bj < 2; ++bj) {
                    const f32x4 a0 = acc[ai][bj][m][0] * scale, a1 = acc[ai][bj][m][1] * scale;
                    u32x4 w; w.x = pk2(a0[0], a0[1]); w.y = pk2(a0[2], a0[3]); w.z = pk2(a1[0], a1[1]); w.w = pk2(a1[2], a1[3]);
                    *(u32x4*)(Y + ((unsigned)(row0 + 128 * ai + 16 * m) * 1024u + (unsigned)(col0 + 128 * bj))) = w;
                }
    }
};

DI bf16x8 ldg8(const bf16_t* p) { return *(const bf16x8*)p; }
DI bf16x8 ldv(const bf16_t* p) { const s16x4 lo = *(const s16x4*)p, hi = *(const s16x4*)(p + 8); return __builtin_shufflevector(lo, hi, 0, 1, 2, 3, 4, 5, 6, 7); }
DI f32x16 zero16() { f32x16 z; for (int i = 0; i < 16; ++i) z[i] = 0.f; return z; }
DI void softmax_step(f32x16& s, float& m, float& l, f32x16& Oa, f32x16& Ob, bf16x8& pa, bf16x8& pb) {
    float t = s[0];
#pragma unroll
    for (int i = 1; i < 16; ++i) t = fmaxf(t, s[i]);
    t = fmaxf(t, xor32(t));
    const float mn = fmaxf(m, t), al = ex2(m - mn); m = mn;
    float sum = 0.f;
#pragma unroll
    for (int i = 0; i < 16; ++i) { const float p = s[i] > -1e29f ? ex2(s[i] - mn) : 0.f; s[i] = p; sum += p; }
    l = l * al + sum; Oa = Oa * al; Ob = Ob * al;
    u32x4 a, b;
    a.x = pk2(s[0], s[1]); a.y = pk2(s[2], s[3]); a.z = pk2(s[4], s[5]); a.w = pk2(s[6], s[7]);
    b.x = pk2(s[8], s[9]); b.y = pk2(s[10], s[11]); b.z = pk2(s[12], s[13]); b.w = pk2(s[14], s[15]);
    pa = __builtin_bit_cast(bf16x8, a); pb = __builtin_bit_cast(bf16x8, b);
}

DI float exp_sum(const f32x16& sa, const f32x16& sb, f32x16& pa, f32x16& pb) {
    f32x2 s2 = {0.f, 0.f};
#pragma unroll
    for (int i = 0; i < 16; i += 2) {
        pa[i] = ex2(sa[i]); pa[i + 1] = ex2(sa[i + 1]); pb[i] = ex2(sb[i]); pb[i + 1] = ex2(sb[i + 1]);
        s2 += (f32x2){pa[i], pa[i + 1]}; s2 += (f32x2){pb[i], pb[i + 1]};
    }
    return s2.x + s2.y;
}
DI void smax64(f32x16& sa, f32x16& sb, float& m, float& l, f32x16& Oa, f32x16& Ob, const bool first, bf16x8 (&p)[4]) {
    f32x16 pa, pb;
    float sum = exp_sum(sa, sb, pa, pb);
    if (first || __ballot(!(sum <= 65536.f)) != 0ull) {
        float t = fmaxf(sa[0], sb[0]);
#pragma unroll
        for (int i = 1; i < 16; ++i) t = fmaxf(t, fmaxf(sa[i], sb[i]));
        t = fmaxf(t, xor32(t));
        const float delta = first ? t : fmaxf(t, 0.f);
        const float al = first ? 1.f : ex2(-delta);
        m += delta; l *= al; Oa = Oa * al; Ob = Ob * al;
#pragma unroll
        for (int i = 0; i < 16; ++i) { sa[i] -= delta; sb[i] -= delta; }
        sum = exp_sum(sa, sb, pa, pb);
    }
    l += sum;
    u32x4 w;
    w.x = pk2(pa[0], pa[1]); w.y = pk2(pa[2], pa[3]); w.z = pk2(pa[4], pa[5]); w.w = pk2(pa[6], pa[7]); p[0] = __builtin_bit_cast(bf16x8, w);
    w.x = pk2(pa[8], pa[9]); w.y = pk2(pa[10], pa[11]); w.z = pk2(pa[12], pa[13]); w.w = pk2(pa[14], pa[15]); p[1] = __builtin_bit_cast(bf16x8, w);
    w.x = pk2(pb[0], pb[1]); w.y = pk2(pb[2], pb[3]); w.z = pk2(pb[4], pb[5]); w.w = pk2(pb[6], pb[7]); p[2] = __builtin_bit_cast(bf16x8, w);
    w.x = pk2(pb[8], pb[9]); w.y = pk2(pb[10], pb[11]); w.z = pk2(pb[12], pb[13]); w.w = pk2(pb[14], pb[15]); p[3] = __builtin_bit_cast(bf16x8, w);
}
DI bf16x8 ldsv(const LAS unsigned char* p) { const s16x4 lo = *(const LAS s16x4*)p, hi = *(const LAS s16x4*)(p + 16); return __builtin_shufflevector(lo, hi, 0, 1, 2, 3, 4, 5, 6, 7); }

constexpr int DKB = 9216, DBUF = 17920;
DI void diff_item(const Args& A, int l, int b, int h, int qb, LAS unsigned char* lds, const int tid) {
    const int lane = tid & 63, wid = tid >> 6, lh = lane >> 5, ln = lane & 31;
    const bf16_t* Q = (const bf16_t*)(A.ws + WS_DFQ); const bf16_t* K = (const bf16_t*)(A.ws + WS_DFK);
    const bf16_t* VT = (const bf16_t*)(A.ws + WS_DFVT) + (size_t)(b * 256 + h * 64) * KV;
    const int qrow = (qb >= 0 ? b * 4096 + qb * 256 : ML + b * 256) + wid * 32 + ln;
    const bf16_t* qp = Q + (size_t)qrow * 256 + h * 64 + 8 * lh;
    const bf16x8 q1a = ldg8(qp), q1b = ldg8(qp + 16), q2a = ldg8(qp + 32), q2b = ldg8(qp + 48);
    const int lk = tid >> 3, lc = tid & 7;
    const bf16_t* kgL = K + (size_t)(b * 4096 + lk) * 256 + h * 64 + lc * 8;
    const bf16_t* kgC = K + (size_t)(ML + b * 256 + lk) * 256 + h * 64 + lc * 8;
    const bf16_t* vg = VT + (size_t)lk * KV + lc * 8;
    LAS unsigned char* kw = lds + lk * 144 + lc * 16;
    LAS unsigned char* vw = lds + DKB + lk * 136 + lc * 16;
    const LAS unsigned char* kr = lds + ln * 144 + lh * 16;
    const LAS unsigned char* vr = lds + DKB + ln * 136 + lh * 8;
    const int st0 = qb >= 0 ? 0 : 64;
    f32x16 O1a = zero16(), O1b = zero16(), O2a = zero16(), O2b = zero16();
    float m1 = 0.f, l1 = 0.f, m2 = 0.f, l2 = 0.f;
    __syncthreads();
    {
        const bf16x8 kreg = ldg8(st0 < 64 ? kgL + (size_t)st0 * 64 * 256 : kgC + (size_t)(st0 - 64) * 64 * 256);
        const bf16x8 vreg = ldg8(vg + st0 * 64);
        *(LAS bf16x8*)kw = kreg;
        const u32x4 vv = __builtin_bit_cast(u32x4, vreg);
        *(LAS u32x2*)vw = (u32x2){vv.x, vv.y}; *(LAS u32x2*)(vw + 8) = (u32x2){vv.z, vv.w};
    }
    __syncthreads();
    for (int st = st0; st < 68; ++st) {
        const int cur = (st - st0) & 1; const bool more = st + 1 < 68, first = st == st0;
        bf16x8 kreg, vreg;
        if (more) { const int sn = st + 1; kreg = ldg8(sn < 64 ? kgL + (size_t)sn * 64 * 256 : kgC + (size_t)(sn - 64) * 64 * 256); vreg = ldg8(vg + sn * 64); }
        const LAS unsigned char* kb = kr + cur * DBUF; const LAS unsigned char* vb = vr + cur * DBUF;
        f32x16 ng1, ng2; { const float n1 = -m1, n2 = -m2;
#pragma unroll
          for (int i = 0; i < 16; ++i) { ng1[i] = n1; ng2[i] = n2; } }
        f32x16 s1a = MFMA32(*(const LAS bf16x8*)(kb), q1a, ng1); s1a = MFMA32(*(const LAS bf16x8*)(kb + 32), q1b, s1a);
        f32x16 s1b = MFMA32(*(const LAS bf16x8*)(kb + 32 * 144), q1a, ng1); s1b = MFMA32(*(const LAS bf16x8*)(kb + 32 * 144 + 32), q1b, s1b);
        f32x16 s2a = MFMA32(*(const LAS bf16x8*)(kb + 64), q2a, ng2); s2a = MFMA32(*(const LAS bf16x8*)(kb + 96), q2b, s2a);
        f32x16 s2b = MFMA32(*(const LAS bf16x8*)(kb + 32 * 144 + 64), q2a, ng2); s2b = MFMA32(*(const LAS bf16x8*)(kb + 32 * 144 + 96), q2b, s2b);
        bf16x8 p[4], r[4];
        smax64(s1a, s1b, m1, l1, O1a, O1b, first, p);
#pragma unroll
        for (int j = 0; j < 2; ++j) {
            O1a = MFMA32(ldsv(vb + 64 * j), p[2 * j], O1a); O1a = MFMA32(ldsv(vb + 64 * j + 32), p[2 * j + 1], O1a);
            O1b = MFMA32(ldsv(vb + 32 * 136 + 64 * j), p[2 * j], O1b); O1b = MFMA32(ldsv(vb + 32 * 136 + 64 * j + 32), p[2 * j + 1], O1b);
        }
        smax64(s2a, s2b, m2, l2, O2a, O2b, first, r);
#pragma unroll
        for (int j = 0; j < 2; ++j) {
            O2a = MFMA32(ldsv(vb + 64 * j), r[2 * j], O2a); O2a = MFMA32(ldsv(vb + 64 * j + 32), r[2 * j + 1], O2a);
            O2b = MFMA32(ldsv(vb + 32 * 136 + 64 * j), r[2 * j], O2b); O2b = MFMA32(ldsv(vb + 32 * 136 + 64 * j + 32), r[2 * j + 1], O2b);
        }
        if (more) {
            *(LAS bf16x8*)(kw + (cur ^ 1) * DBUF) = kreg;
            const u32x4 vv = __builtin_bit_cast(u32x4, vreg);
            *(LAS u32x2*)(vw + (cur ^ 1) * DBUF) = (u32x2){vv.x, vv.y}; *(LAS u32x2*)(vw + (cur ^ 1) * DBUF + 8) = (u32x2){vv.z, vv.w};
        }
        __syncthreads();
    }
    l1 += xor32(l1); l2 += xor32(l2);
    const float* lt = (const float*)(A.ws + WS_LAM);
    const float i1 = 1.f / l1, i2 = lt[2 * l] / l2, oml = lt[2 * l + 1];
    float ss = 0.f;
#pragma unroll
    for (int i = 0; i < 16; ++i) { O1a[i] = O1a[i] * i1 - O2a[i] * i2; O1b[i] = O1b[i] * i1 - O2b[i] * i2; ss += O1a[i] * O1a[i] + O1b[i] * O1b[i]; }
    ss += xor32(ss);
    const float rn = rsqrtf(ss * (1.f / 64.f) + 1e-6f) * oml;
    const float* g = A.in[19] + l * 64;
    bf16_t* Y = (bf16_t*)(A.ws + WS_H) + (size_t)qrow * 1024 + 768 + h * 64;
#pragma unroll
    for (int ig = 0; ig < 4; ++ig) {
        const int d = 8 * ig + 4 * lh;
        const f32x4 ga = *(const f32x4*)(g + d), gb = *(const f32x4*)(g + 32 + d);
        u32x2 wa, wb;
        wa.x = pk2(O1a[4 * ig] * rn * ga.x, O1a[4 * ig + 1] * rn * ga.y); wa.y = pk2(O1a[4 * ig + 2] * rn * ga.z, O1a[4 * ig + 3] * rn * ga.w);
        wb.x = pk2(O1b[4 * ig] * rn * gb.x, O1b[4 * ig + 1] * rn * gb.y); wb.y = pk2(O1b[4 * ig + 2] * rn * gb.z, O1b[4 * ig + 3] * rn * gb.w);
        *(u32x2*)(Y + d) = wa; *(u32x2*)(Y + 32 + d) = wb;
    }
}

DI void na_item(const Args& A, int l, int b, int h, int rb, LAS unsigned char* lds, LAS float* rpb_s, const int tid) {
    const int lane = tid & 63, wid = __builtin_amdgcn_readfirstlane(tid >> 6), lh = lane >> 5, ln = lane & 31;
    __syncthreads();
    for (int i = tid; i < 465; i += 512) rpb_s[i] = A.in[10][(l * 4 + h) * 465 + i] * LOG2E;
    const bf16_t* Q = (const bf16_t*)(A.ws + WS_NAQ); const bf16_t* K = (const bf16_t*)(A.ws + WS_NAK);
    const bf16_t* VT = (const bf16_t*)(A.ws + WS_NAVT) + (size_t)(b * 256 + h * 64) * KV;
    const bool lat = rb >= 0;
    const int r = rb * 4 + (wid >> 1), qc = (wid & 1) * 32 + ln;
    const int qrow = lat ? b * 4096 + r * 64 + qc : ML + b * 256 + wid * 32 + ln;
    const bf16_t* qp = Q + (size_t)qrow * 256 + h * 64 + 8 * lh;
    const bf16x8 q0 = ldg8(qp), q1 = ldg8(qp + 16), q2 = ldg8(qp + 32), q3 = ldg8(qp + 48);
    const int rs = min(max(r - 4, 0), 56), cs = min(max(qc - 8, 0), 48);
    const int rmin = lat ? min(max(4 * rb - 4, 0), 56) : 0;
    const int nloc = lat ? min(max(4 * rb - 1, 0), 56) + 8 - rmin : 0;
    const int nst = nloc + 4;
    const int lk = tid >> 3, lc = tid & 7;
    const bf16_t* kgL = K + (size_t)(b * 4096 + rmin * 64 + lk) * 256 + h * 64 + lc * 8;
    const bf16_t* kgC = K + (size_t)(ML + b * 256 + lk) * 256 + h * 64 + lc * 8;
    const bf16_t* vg = VT + (size_t)lk * KV + lc * 8;
    LAS unsigned char* kw = lds + lk * 144 + lc * 16;
    LAS unsigned char* vw = lds + DKB + lk * 136 + lc * 16;
    const LAS unsigned char* kr = lds + ln * 144 + lh * 16;
    const LAS unsigned char* vr = lds + DKB + ln * 136 + lh * 8;
    f32x16 Oa = zero16(), Ob = zero16(); float m = 0.f, ls = 0.f; bool started = false;
    {
        const bf16x8 kreg = ldg8(nloc > 0 ? kgL : kgC);
        const bf16x8 vreg = ldg8(vg + (nloc > 0 ? rmin * 64 : 4096));
        *(LAS bf16x8*)kw = kreg;
        const u32x4 vv = __builtin_bit_cast(u32x4, vreg);
        *(LAS u32x2*)vw = (u32x2){vv.x, vv.y}; *(LAS u32x2*)(vw + 8) = (u32x2){vv.z, vv.w};
    }
    __syncthreads();
    for (int j = 0; j < nst; ++j) {
        const int cur = j & 1; const bool more = j + 1 < nst;
        bf16x8 kreg, vreg;
        if (more) { const int jn = j + 1; kreg = ldg8(jn < nloc ? kgL + (size_t)jn * 64 * 256 : kgC + (size_t)(jn - nloc) * 64 * 256); vreg = ldg8(vg + (jn < nloc ? (rmin + jn) * 64 : 4096 + (jn - nloc) * 64)); }
        const bool loc = j < nloc; const int krow = rmin + j;
        if (!loc || (krow >= rs && krow < rs + 8)) {
            const LAS unsigned char* kb = kr + cur * DBUF; const LAS unsigned char* vb = vr + cur * DBUF;
            f32x16 sa = MFMA32(*(const LAS bf16x8*)(kb), q0, zero16()); sa = MFMA32(*(const LAS bf16x8*)(kb + 32), q1, sa);
            sa = MFMA32(*(const LAS bf16x8*)(kb + 64), q2, sa); sa = MFMA32(*(const LAS bf16x8*)(kb + 96), q3, sa);
            f32x16 sb = MFMA32(*(const LAS bf16x8*)(kb + 32 * 144), q0, zero16()); sb = MFMA32(*(const LAS bf16x8*)(kb + 32 * 144 + 32), q1, sb);
            sb = MFMA32(*(const LAS bf16x8*)(kb + 32 * 144 + 64), q2, sb); sb = MFMA32(*(const LAS bf16x8*)(kb + 32 * 144 + 96), q3, sb);
            if (loc) {
                const int dr = krow - r + 7;
#pragma unroll
                for (int i = 0; i < 16; ++i) {
                    const int kc = (i & 3) + 8 * (i >> 2) + 4 * lh;
                    const bool va = kc >= cs && kc < cs + 16, vb2 = kc + 32 >= cs && kc + 32 < cs + 16;
                    const int da = min(max(kc - qc + 15, 0), 30), db = min(max(kc + 32 - qc + 15, 0), 30);
                    sa[i] = va ? sa[i] + rpb_s[dr * 31 + da] - m : -1e30f;
                    sb[i] = vb2 ? sb[i] + rpb_s[dr * 31 + db] - m : -1e30f;
                }
            } else {
#pragma unroll
                for (int i = 0; i < 16; ++i) { sa[i] -= m; sb[i] -= m; }
            }
            bf16x8 p[4];
            smax64(sa, sb, m, ls, Oa, Ob, !started, p); started = true;
#pragma unroll
            for (int jj = 0; jj < 2; ++jj) {
                Oa = MFMA32(ldsv(vb + 64 * jj), p[2 * jj], Oa); Oa = MFMA32(ldsv(vb + 64 * jj + 32), p[2 * jj + 1], Oa);
                Ob = MFMA32(ldsv(vb + 32 * 136 + 64 * jj), p[2 * jj], Ob); Ob = MFMA32(ldsv(vb + 32 * 136 + 64 * jj + 32), p[2 * jj + 1], Ob);
            }
        }
        if (more) {
            *(LAS bf16x8*)(kw + (cur ^ 1) * DBUF) = kreg;
            const u32x4 vv = __builtin_bit_cast(u32x4, vreg);
            *(LAS u32x2*)(vw + (cur ^ 1) * DBUF) = (u32x2){vv.x, vv.y}; *(LAS u32x2*)(vw + (cur ^ 1) * DBUF + 8) = (u32x2){vv.z, vv.w};
        }
        __syncthreads();
    }
    ls += xor32(ls);
    const float inv = 1.f / ls;
    bf16_t* Y = (bf16_t*)(A.ws + WS_H) + (size_t)qrow * 1024 + 256 + h * 64;
#pragma unroll
    for (int ig = 0; ig < 4; ++ig) {
        const int d = 8 * ig + 4 * lh;
        u32x2 wa, wb;
        wa.x = pk2(Oa[4 * ig] * inv, Oa[4 * ig + 1] * inv); wa.y = pk2(Oa[4 * ig + 2] * inv, Oa[4 * ig + 3] * inv);
        wb.x = pk2(Ob[4 * ig] * inv, Ob[4 * ig + 1] * inv); wb.y = pk2(Ob[4 * ig + 2] * inv, Ob[4 * ig + 3] * inv);
        *(u32x2*)(Y + d) = wa; *(u32x2*)(Y + 32 + d) = wb;
    }
}

DI void smax32(f32x16& sa, float& m, float& l, f32x16& Oa, f32x16& Ob, bool& started, bf16x8 (&p)[2]) {
    f32x16 pa; f32x2 s2 = {0.f, 0.f};
#pragma unroll
    for (int i = 0; i < 16; i += 2) { pa[i] = ex2(sa[i]); pa[i + 1] = ex2(sa[i + 1]); s2 += (f32x2){pa[i], pa[i + 1]}; }
    float sum = s2.x + s2.y;
    if (__ballot(!(sum <= 65536.f) || !started) != 0ull) {
        float t = sa[0];
#pragma unroll
        for (int i = 1; i < 16; ++i) t = fmaxf(t, sa[i]);
        t = fmaxf(t, xor32(t));
        const bool has = t > -1e29f;
        const float delta = started ? fmaxf(t, 0.f) : (has ? t : 0.f);
        const float al = started ? ex2(-delta) : 1.f;
        m += delta; l *= al; Oa = Oa * al; Ob = Ob * al;
        started = started || has;
        s2 = (f32x2){0.f, 0.f};
#pragma unroll
        for (int i = 0; i < 16; i += 2) { pa[i] = ex2(sa[i] - delta); pa[i + 1] = ex2(sa[i + 1] - delta); s2 += (f32x2){pa[i], pa[i + 1]}; }
        sum = s2.x + s2.y;
    }
    l += sum;
    u32x4 w;
    w.x = pk2(pa[0], pa[1]); w.y = pk2(pa[2], pa[3]); w.z = pk2(pa[4], pa[5]); w.w = pk2(pa[6], pa[7]); p[0] = __builtin_bit_cast(bf16x8, w);
    w.x = pk2(pa[8], pa[9]); w.y = pk2(pa[10], pa[11]); w.z = pk2(pa[12], pa[13]); w.w = pk2(pa[14], pa[15]); p[1] = __builtin_bit_cast(bf16x8, w);
}

DI void na_item_lat(const Args& A, int l, int b, int h, int rb, LAS unsigned char* lds, LAS float* rpb_s, const int tid) {
    const int lane = tid & 63, wid = __builtin_amdgcn_readfirstlane(tid >> 6), lh = lane >> 5, ln = lane & 31;
    __syncthreads();
    for (int i = tid; i < 465; i += 512) rpb_s[i] = A.in[10][(l * 4 + h) * 465 + i] * LOG2E;
    const bf16_t* Q = (const bf16_t*)(A.ws + WS_NAQ); const bf16_t* K = (const bf16_t*)(A.ws + WS_NAK);
    const bf16_t* VT = (const bf16_t*)(A.ws + WS_NAVT) + (size_t)(b * 256 + h * 64) * KV;
    const int ra = rb * 4 + 2 * (wid >> 2), jg = wid & 3;
    const int r = ra + (ln >> 4), qc = 16 * jg + (ln & 15);
    const int qrow = b * 4096 + r * 64 + qc;
    const bf16_t* qp = Q + (size_t)qrow * 256 + h * 64 + 8 * lh;
    const bf16x8 q0 = ldg8(qp), q1 = ldg8(qp + 16), q2 = ldg8(qp + 32), q3 = ldg8(qp + 48);
    const int rsl = min(max(r - 4, 0), 56), cs = min(max(qc - 8, 0), 48);
    const int w0 = min(max(ra - 4, 0), 56), w1 = min(max(ra - 3, 0), 56) + 8;
    const int t0 = min(max(16 * jg - 8, 0), 32);
    unsigned cmask = 0u;
#pragma unroll
    for (int i = 0; i < 16; ++i) { const int kc = t0 + (i & 3) + 8 * (i >> 2) + 4 * lh; cmask |= (kc >= cs && kc < cs + 16) ? (1u << i) : 0u; }
    const int cbase = t0 + 4 * lh - qc + 15;
    const int rmin = min(max(4 * rb - 4, 0), 56);
    const int nloc = min(max(4 * rb - 1, 0), 56) + 8 - rmin;
    const int nst = nloc + 4;
    const int lk = tid >> 3, lc = tid & 7;
    const bf16_t* kgL = K + (size_t)(b * 4096 + rmin * 64 + lk) * 256 + h * 64 + lc * 8;
    const bf16_t* kgC = K + (size_t)(ML + b * 256 + lk) * 256 + h * 64 + lc * 8;
    const bf16_t* vg = VT + (size_t)lk * KV + lc * 8;
    LAS unsigned char* kw = lds + lk * 144 + lc * 16;
    LAS unsigned char* vw = lds + DKB + lk * 136 + lc * 16;
    const LAS unsigned char* kr = lds + ln * 144 + lh * 16;
    const LAS unsigned char* vr = lds + DKB + ln * 136 + lh * 8;
    f32x16 Oa = zero16(), Ob = zero16(); float m = 0.f, ls = 0.f; bool started = false;
#define NA_KSRC(jn) ((jn) < nloc ? kgL + (size_t)(jn) * 64 * 256 : kgC + (size_t)((jn) - nloc) * 64 * 256)
#define NA_VSRC(jn) (vg + ((jn) < nloc ? (rmin + (jn)) * 64 : 4096 + ((jn) - nloc) * 64))
    bf16x8 kA, vA, kB, vB;
    {
        const bf16x8 kreg = ldg8(NA_KSRC(0));
        const bf16x8 vreg = ldg8(NA_VSRC(0));
        kA = ldg8(NA_KSRC(1)); vA = ldg8(NA_VSRC(1));
        *(LAS bf16x8*)kw = kreg;
        const u32x4 vv = __builtin_bit_cast(u32x4, vreg);
        *(LAS u32x2*)vw = (u32x2){vv.x, vv.y}; *(LAS u32x2*)(vw + 8) = (u32x2){vv.z, vv.w};
    }
    kB = kA; vB = vA;
    __syncthreads();
    for (int j = 0; j < nst; ++j) {
        const int cur = j & 1; const bool more = j + 1 < nst;
        if (j + 2 < nst) { kB = ldg8(NA_KSRC(j + 2)); vB = ldg8(NA_VSRC(j + 2)); }
        const bool loc = j < nloc; const int krow = rmin + j;
        const LAS unsigned char* kb = kr + cur * DBUF; const LAS unsigned char* vb = vr + cur * DBUF;
        if (loc) {
            if (krow >= w0 && krow < w1) {
                const LAS unsigned char* kt = kb + t0 * 144; const LAS unsigned char* vt = vb + t0 * 2;
                f32x16 sa = MFMA32(*(const LAS bf16x8*)(kt), q0, zero16()); sa = MFMA32(*(const LAS bf16x8*)(kt + 32), q1, sa);
                sa = MFMA32(*(const LAS bf16x8*)(kt + 64), q2, sa); sa = MFMA32(*(const LAS bf16x8*)(kt + 96), q3, sa);
                const bool rv = krow >= rsl && krow < rsl + 8;
                const LAS float* rp = rpb_s + ((krow - r + 7) * 31 + cbase);
#pragma unroll
                for (int i = 0; i < 16; ++i) sa[i] = (rv && ((cmask >> i) & 1u)) ? sa[i] + rp[(i & 3) + 8 * (i >> 2)] - m : -1e30f;
                bf16x8 p[2];
                smax32(sa, m, ls, Oa, Ob, started, p);
                Oa = MFMA32(ldsv(vt), p[0], Oa); Oa = MFMA32(ldsv(vt + 32), p[1], Oa);
                Ob = MFMA32(ldsv(vt + 32 * 136), p[0], Ob); Ob = MFMA32(ldsv(vt + 32 * 136 + 32), p[1], Ob);
            }
        } else {
            f32x16 sa = MFMA32(*(const LAS bf16x8*)(kb), q0, zero16()); sa = MFMA32(*(const LAS bf16x8*)(kb + 32), q1, sa);
            sa = MFMA32(*(const LAS bf16x8*)(kb + 64), q2, sa); sa = MFMA32(*(const LAS bf16x8*)(kb + 96), q3, sa);
            f32x16 sb = MFMA32(*(const LAS bf16x8*)(kb + 32 * 144), q0, zero16()); sb = MFMA32(*(const LAS bf16x8*)(kb + 32 * 144 + 32), q1, sb);
            sb = MFMA32(*(const LAS bf16x8*)(kb + 32 * 144 + 64), q2, sb); sb = MFMA32(*(const LAS bf16x8*)(kb + 32 * 144 + 96), q3, sb);
#pragma unroll
            for (int i = 0; i < 16; ++i) { sa[i] -= m; sb[i] -= m; }
            bf16x8 p[4];
            smax64(sa, sb, m, ls, Oa, Ob, false, p);
#pragma unroll
            for (int jj = 0; jj < 2; ++jj) {
                Oa = MFMA32(ldsv(vb + 64 * jj), p[2 * jj], Oa); Oa = MFMA32(ldsv(vb + 64 * jj + 32), p[2 * jj + 1], Oa);
                Ob = MFMA32(ldsv(vb + 32 * 136 + 64 * jj), p[2 * jj], Ob); Ob = MFMA32(ldsv(vb + 32 * 136 + 64 * jj + 32), p[2 * jj + 1], Ob);
            }
        }
        if (more) {
            *(LAS bf16x8*)(kw + (cur ^ 1) * DBUF) = kA;
            const u32x4 vv = __builtin_bit_cast(u32x4, vA);
            *(LAS u32x2*)(vw + (cur ^ 1) * DBUF) = (u32x2){vv.x, vv.y}; *(LAS u32x2*)(vw + (cur ^ 1) * DBUF + 8) = (u32x2){vv.z, vv.w};
        }
        __syncthreads();
        kA = kB; vA = vB;
    }
#undef NA_KSRC
#undef NA_VSRC
    ls += xor32(ls);
    const float inv = 1.f / ls;
    bf16_t* Y = (bf16_t*)(A.ws + WS_H) + (size_t)qrow * 1024 + 256 + h * 64;
#pragma unroll
    for (int ig = 0; ig < 4; ++ig) {
        const int d = 8 * ig + 4 * lh;
        u32x2 wa, wb;
        wa.x = pk2(Oa[4 * ig] * inv, Oa[4 * ig + 1] * inv); wa.y = pk2(Oa[4 * ig + 2] * inv, Oa[4 * ig + 3] * inv);
        wb.x = pk2(Ob[4 * ig] * inv, Ob[4 * ig + 1] * inv); wb.y = pk2(Ob[4 * ig + 2] * inv, Ob[4 * ig + 3] * inv);
        *(u32x2*)(Y + d) = wa; *(u32x2*)(Y + 32 + d) = wb;
    }
}

DI void sgu_item(const Args& A, int l, int ci, LAS unsigned char* lds, const int tid) {
    const int lane = tid & 63, wid = __builtin_amdgcn_readfirstlane(tid >> 6), lh = lane >> 5, ln = lane & 31;
    const int row0 = ci * 128;
    LAS bf16_t* vT = (LAS bf16_t*)lds;
    const bf16_t* SV = (const bf16_t*)(A.ws + WS_SGV); const bf16_t* SU = (const bf16_t*)(A.ws + WS_SGU);
    const f32x4 lg = *(const f32x4*)(A.in[11] + l * 256 + lane * 4), lb = *(const f32x4*)(A.in[12] + l * 256 + lane * 4);
    const int g = wid >> 1, ph = wid & 1;
    bf16x8 bfr[2][8];
    {
        const bf16_t* Wb = (const bf16_t*)(A.ws + WS_SGW) + (size_t)((l * 4 + g) * 128 + 64 * ph + ln) * 128 + 8 * lh;
#pragma unroll
        for (int pt = 0; pt < 2; ++pt)
#pragma unroll
            for (int ks = 0; ks < 8; ++ks) bfr[pt][ks] = ldg8(Wb + (size_t)pt * 32 * 128 + 16 * ks);
    }
    __syncthreads();
#pragma unroll 1
    for (int i4 = 0; i4 < 4; ++i4) {
        const int q0 = wid * 16 + 4 * i4;
        float x[4][4], mu[4], var[4];
#pragma unroll
        for (int rr = 0; rr < 4; ++rr) {
            const u32x2 raw = *(const u32x2*)(SV + (size_t)(row0 + q0 + rr) * 256 + lane * 4);
            x[rr][0] = bf2f(raw.x & 0xffffu); x[rr][1] = bf2f(raw.x >> 16); x[rr][2] = bf2f(raw.y & 0xffffu); x[rr][3] = bf2f(raw.y >> 16);
            mu[rr] = x[rr][0] + x[rr][1] + x[rr][2] + x[rr][3];
        }
#pragma unroll
        for (int o = 32; o > 0; o >>= 1)
#pragma unroll
            for (int rr = 0; rr < 4; ++rr) mu[rr] += __shfl_xor(mu[rr], o);
#pragma unroll
        for (int rr = 0; rr < 4; ++rr) {
            mu[rr] *= (1.f / 256.f);
#pragma unroll
            for (int j = 0; j < 4; ++j) x[rr][j] -= mu[rr];
            var[rr] = x[rr][0] * x[rr][0] + x[rr][1] * x[rr][1] + x[rr][2] * x[rr][2] + x[rr][3] * x[rr][3];
        }
#pragma unroll
        for (int o = 32; o > 0; o >>= 1)
#pragma unroll
            for (int rr = 0; rr < 4; ++rr) var[rr] += __shfl_xor(var[rr], o);
        float rn[4];
#pragma unroll
        for (int rr = 0; rr < 4; ++rr) rn[rr] = rsqrtf(var[rr] * (1.f / 256.f) + 1e-6f);
#pragma unroll
        for (int j = 0; j < 4; ++j) {
            const float gj = lg[j], bj = lb[j];
            u32x2 w; w.x = pk2(x[0][j] * rn[0] * gj + bj, x[1][j] * rn[1] * gj + bj); w.y = pk2(x[2][j] * rn[2] * gj + bj, x[3][j] * rn[3] * gj + bj);
            *(LAS u32x2*)(vT + (lane * 4 + j) * 136 + q0) = w;
        }
    }
    __syncthreads();
    f32x16 acc[2][2];
#pragma unroll
    for (int ct = 0; ct < 2; ++ct)
#pragma unroll
        for (int pt = 0; pt < 2; ++pt) acc[ct][pt] = zero16();
#pragma unroll
    for (int ks = 0; ks < 8; ++ks) {
        bf16x8 af[2];
#pragma unroll
        for (int ct = 0; ct < 2; ++ct) af[ct] = *(const LAS bf16x8*)(vT + (g * 64 + 32 * ct + ln) * 136 + 16 * ks + 8 * lh);
#pragma unroll
        for (int ct = 0; ct < 2; ++ct)
#pragma unroll
            for (int pt = 0; pt < 2; ++pt) acc[ct][pt] = MFMA32(af[ct], bfr[pt][ks], acc[ct][pt]);
    }
    bf16_t* Y = (bf16_t*)(A.ws + WS_H);
#pragma unroll
    for (int pt = 0; pt < 2; ++pt) {
        const int p = 64 * ph + 32 * pt + ln;
        const float bias = A.in[14][(l * 4 + g) * 128 + p];
#pragma unroll
        for (int ct = 0; ct < 2; ++ct)
#pragma unroll
            for (int ig = 0; ig < 4; ++ig) {
                const int c = g * 64 + 32 * ct + 8 * ig + 4 * lh;
                const u32x2 raw = *(const u32x2*)(SU + (size_t)(row0 + p) * 256 + c);
                const float u0 = bf2f(raw.x & 0xffffu), u1 = bf2f(raw.x >> 16), u2 = bf2f(raw.y & 0xffffu), u3 = bf2f(raw.y >> 16);
                u32x2 o; o.x = pk2(u0 * (acc[ct][pt][4 * ig] + bias), u1 * (acc[ct][pt][4 * ig + 1] + bias));
                o.y = pk2(u2 * (acc[ct][pt][4 * ig + 2] + bias), u3 * (acc[ct][pt][4 * ig + 3] + bias));
                *(u32x2*)(Y + (size_t)(row0 + p) * 1024 + 512 + c) = o;
            }
    }
}

#define XB_TMO      128
#define XB_XCNT(j)  (256  + 64 * (j))
#define XB_XSUB(j)  (1280 + 64 * (j))
#define XB_XGEN(j)  (2304 + 64 * (j))
#define XB_TOP      3328
#define XB_TOPGEN   3392
#define XCD_BAR_WORDS 3456
#define XB_SPIN_CAP (1u << 18)

__device__ __forceinline__ unsigned xb_ld(unsigned* p)              { return __hip_atomic_load(p, __ATOMIC_RELAXED, __HIP_MEMORY_SCOPE_AGENT); }
__device__ __forceinline__ unsigned xb_add(unsigned* p, unsigned v) { return __hip_atomic_fetch_add(p, v, __ATOMIC_RELAXED, __HIP_MEMORY_SCOPE_AGENT); }
__device__ __forceinline__ unsigned xb_xcc_id() { return (unsigned)__builtin_amdgcn_s_getreg((3 << 11) | 20) & 0xFu; }
#define XB_SPIN(cond, bar) do { unsigned _sp = 0; while (cond) { __builtin_amdgcn_s_sleep(1); \
    if ((++_sp & 255u) == 0u) { if (xb_ld(&(bar)[XB_TMO])) break; if (_sp > XB_SPIN_CAP) { atomicAdd(&(bar)[XB_TMO], 1u); break; } } } } while (0)

struct XcdBarrier {
    unsigned* bar; unsigned x;
    volatile LAS unsigned* st;
};

__device__ __forceinline__ XcdBarrier xcd_barrier_post(unsigned* bar, volatile LAS unsigned* st) {
    XcdBarrier b; b.bar = bar; b.x = xb_xcc_id(); b.st = st;
    if (threadIdx.x == 0) (void)xb_add(&bar[XB_XCNT(b.x)], 1u);
    return b;
}
__device__ __forceinline__ void xcd_barrier_complete(unsigned* bar, unsigned x, unsigned& nloc, unsigned& nx) {
    const unsigned G = gridDim.x * gridDim.y * gridDim.z;
    unsigned sum, cnt, mine, sp = 0u;
    for (;;) {
        sum = 0u; cnt = 0u; mine = 0u;
#pragma unroll
        for (unsigned j = 0; j < 16; ++j) { const unsigned c = xb_ld(&bar[XB_XCNT(j)]); sum += c; cnt += (c > 0u) ? 1u : 0u; mine = (j == x) ? c : mine; }
        if (sum == G) break;
        __builtin_amdgcn_s_sleep(1);
        if ((++sp & 255u) == 0u) { if (xb_ld(&bar[XB_TMO])) break; if (sp > XB_SPIN_CAP) { atomicAdd(&bar[XB_TMO], 1u); break; } }
    }
    nloc = mine > 0u ? mine : 1u; nx = cnt > 0u ? cnt : 1u;
}

__device__ __forceinline__ void xcd_barrier(const XcdBarrier& b) {
    asm volatile("s_waitcnt vmcnt(0)" ::: "memory");
    __syncthreads();
    if (threadIdx.x == 0) {
        unsigned* bar = b.bar;
        __builtin_amdgcn_s_waitcnt(0);
        unsigned nloc = b.st[0], nx = b.st[1];
        if (nloc == 0u) { xcd_barrier_complete(bar, b.x, nloc, nx); b.st[0] = nloc; b.st[1] = nx; }
        const unsigned old = xb_add(&bar[XB_XSUB(b.x)], 1u);
        const unsigned gen = old / nloc;
        if (old + 1u == (gen + 1u) * nloc) {
            __builtin_amdgcn_fence(__ATOMIC_RELEASE, "agent");
            asm volatile("s_waitcnt vmcnt(0)" ::: "memory");
            const unsigned og = xb_add(&bar[XB_TOP], 1u);
            const unsigned tg = og / nx;
            if (og + 1u == (tg + 1u) * nx) xb_add(&bar[XB_TOPGEN], 1u);
            else XB_SPIN(xb_ld(&bar[XB_TOPGEN]) == tg, bar);
            __builtin_amdgcn_fence(__ATOMIC_ACQUIRE, "agent");
            xb_add(&bar[XB_XGEN(b.x)], 1u);
            asm volatile("s_waitcnt vmcnt(0)" ::: "memory");
        } else {
            XB_SPIN(xb_ld(&bar[XB_XGEN(b.x)]) == gen, bar);
            __builtin_amdgcn_fence(__ATOMIC_ACQUIRE, "agent");
            asm volatile("s_waitcnt vmcnt(0)" ::: "memory");
        }
    }
    __syncthreads();
}

DI void phase_mix(const Args& A, int l, LAS unsigned char* lds, int rep) {
    const bool last = l == DEPTH - 1;
    const int nF = 256, nD = 512, nN = 512, nS = last ? 256 : 272, nFc = last ? 0 : 8, nDc = last ? 0 : 32, nNc = last ? 0 : 32;
    const int e0 = nF, e1 = e0 + nD, e2 = e1 + nN, e3 = e2 + nS, e4 = e3 + nFc, e5 = e4 + nDc, e6 = e5 + nNc, e7 = e6 + (last ? 0 : 704);
    unsigned* ctr = (unsigned*)(A.ws + WS_CTL) + l * 64 + rep * 16;
    LAS int* s_item = (LAS int*)(lds + MISC_OFF);
    LAS float* rpb_s = (LAS float*)(lds + RPB_OFF);
    bf16_t* Y = (bf16_t*)(A.ws + WS_H);
    for (;;) {
        __syncthreads();
        if (threadIdx.x == 0) *s_item = (int)atomicAdd(ctr, 1u);
        __syncthreads();
        const int it = *s_item;
        if (it >= e7) break;
        int tid = threadIdx.x; asm volatile("" : "+v"(tid));
#if PROBE_KIND >= 0
        { const int kind = (it < e0 || (it >= e3 && it < e4)) ? 0 : ((it < e1 || (it >= e4 && it < e5)) ? 1 : (it < e3 ? 3 : 2)); if (rep && kind != PROBE_KIND) continue; }
#endif
        if (it < e0 || (it >= e3 && it < e4)) {
            const bool c = it >= e3;
            pg8::Gemm g{(const bf16_t*)(A.ws + (c ? WS_CSC : WS_CS)), (const bf16_t*)(A.ws + (c ? WS_PQTC : WS_PQT)), c ? 256 : 512, c ? 2048 : 32768, 512};
            OneUnit S{{c ? 0 : (it & 1), c ? it - e3 : (it >> 1)}}; EpiFour E{Y, ML, 256, 1.f / 128.f, c ? 1 : 0};
            if (EN_F) pg8::gemm_phase<EpiFour, OneUnit, true, true>(lds, g, S, E, tid);
        } else if (it < e1) { const int j = it - e0; if (EN_D) diff_item(A, l, j >> 6, (j >> 4) & 3, j & 15, lds, tid); }
        else if (it < e2) { const int j = it - e1; if (EN_N) na_item_lat(A, l, j >> 6, (j >> 4) & 3, j & 15, lds, rpb_s, tid); }
        else if (it < e3) { if (EN_S) sgu_item(A, l, it - e2, lds, tid); }
        else if (it < e5) { const int j = it - e4; if (EN_D) diff_item(A, l, j >> 2, j & 3, -1, lds, tid); }
        else if (it < e6) { const int j = it - e5; if (EN_N) na_item(A, l, j >> 2, j & 3, -1, lds, rpb_s, tid); }
        else transpose_tile(A, l + 1, it - e6, lds, tid);
    }
}

constexpr int N_PHASES = 2 + 7 * DEPTH;
__global__ void __launch_bounds__(512, 2) mk_fwd(Args A) {
    extern __shared__ __attribute__((aligned(16))) unsigned char lds_raw[];
    LAS unsigned char* lds = (LAS unsigned char*)lds_raw;
    unsigned char* ws = A.ws;
    float* cx = (float*)(ws + WS_CX);
    const float* MOD = (const float*)(ws + WS_MOD);
    volatile LAS unsigned* bst = (volatile LAS unsigned*)(lds + MISC_OFF + 16);
    if (threadIdx.x == 0) { bst[0] = 0u; bst[1] = 0u; }
    __syncthreads();
    const XcdBarrier bar = xcd_barrier_post((unsigned*)(ws + WS_CTL) + 1024, bst);
    for (int ph = A.ph_lo; ph < A.ph_hi; ++ph) {
        if (ph > A.ph_lo) { if (A.ph_lo < 0) cg::this_grid().sync(); else xcd_barrier(bar); }
        int tid = threadIdx.x; asm volatile("" : "+v"(tid));
        if (ph == 0) { if (EN_P) phase_prologue(A, lds, tid);
#if PROBE_P0
            xcd_barrier(bar); tid = threadIdx.x; asm volatile("" : "+v"(tid)); phase_prologue(A, lds, tid, PROBE_P0);
#endif
            continue; }
        if (ph == N_PHASES - 1) {
#if PROBE_SYNC
            for (int q = 0; q < 32; ++q) xcd_barrier(bar);
#endif
            phase_final(A, tid); continue; }
        const int l = (ph - 1) / 7, s = (ph - 1) % 7; const bool last = l == DEPTH - 1;
        const float* xl = l == 0 ? A.in[0] : A.out;
        const int Mrows = last ? ML : MT;
        const float* mod = MOD + (size_t)l * 9 * 6144;
#if PROBE_S >= 0
        for (int rep = 0; rep < ((s == PROBE_S) ? 2 : 1); ++rep) {
        if (rep) { xcd_barrier(bar); tid = threadIdx.x; asm volatile("" : "+v"(tid)); }
#else
        { const int rep = 0;
#endif
        if (s == 0) phase_norm(A, l, 0, MT, xl, cx, l > 0 ? MOD + (size_t)((l - 1) * 9 + 8) * 6144 + 5 * 1024 : nullptr, tid);
        else if (s == 1) {
            LAS float* rope = (LAS float*)(lds + ROPE_OFF);
            { const int i = tid, pos = i >> 3, f = i & 7; const float ang = (float)pos * exp2f(-(float)f * (13.287712379549449f / 8.f));
              float t = ang * 0.15915494309189535f; t -= floorf(t); rope[2 * i] = __builtin_amdgcn_cosf(t); rope[2 * i + 1] = __builtin_amdgcn_sinf(t); }
            __syncthreads();
            pg8::Gemm g{(const bf16_t*)(ws + WS_H), (const bf16_t*)(ws + WS_WIN) + (size_t)l * NIN * 1024, MT, NIN, 1024};
            pg8::StaticOrder S; S.init(MT, NIN, gridDim.x, blockIdx.x); EpiIn E{ws, rope};
            if (EN_I) pg8::gemm_phase<EpiIn, pg8::StaticOrder, true, true>(lds, g, S, E, tid);
        } else if (s == 2) phase_mix(A, l, lds, rep);
        else if (s == 3 || s == 6) {
            const bool o = s == 3;
            const bf16_t* Aop = (const bf16_t*)(ws + (o ? WS_H : WS_U));
            const bf16_t* Bop = o ? (const bf16_t*)(ws + WS_WOUT) + (size_t)l * 1024 * 1024 : (const bf16_t*)(ws + WS_WFF2) + (size_t)l * 1024 * 4096;
            const int Kf = o ? 1024 : 4096;
            if (!last) {
                const int ksh = o ? 9 : 11;
                pg8::Gemm g2{Aop, Bop, MT, 1024, Kf / 4, Kf};
                SplitOrder S2{ksh, (int)gridDim.x, (int)blockIdx.x}; EpiPartial E2{(float*)(ws + WS_PB), ksh};
                pg8::gemm_phase<EpiPartial, SplitOrder, true, true>(lds, g2, S2, E2, tid);
                tid = threadIdx.x; asm volatile("" : "+v"(tid));
            }
            pg8::Gemm g{Aop, Bop, ML, 1024, Kf, Kf};
            pg8::StaticOrder S; S.init(ML, 1024, gridDim.x, blockIdx.x); EpiRes E{o ? xl : A.out, cx, A.out, cx, mod + (o ? 2 : 5) * 1024};
            if (EN_R) pg8::gemm_phase<EpiRes, pg8::StaticOrder, true, true>(lds, g, S, E, tid);
        } else if (s == 4) phase_norm(A, l, 1, Mrows, A.out, cx, mod + 8 * 6144 + 2 * 1024, tid);
        else if (s == 5) {
            pg8::Gemm g{(const bf16_t*)(ws + WS_H), (const bf16_t*)(ws + WS_WFF1) + (size_t)l * 4096 * 1024, Mrows, 4096, 1024};
            pg8::StaticOrder S; S.init(Mrows, 4096, gridDim.x, blockIdx.x); EpiFF1 E{(bf16_t*)(ws + WS_U)};
            if (EN_1) pg8::gemm_phase<EpiFF1, pg8::StaticOrder, true, true>(lds, g, S, E, tid);
        }
        }
    }
}

extern "C" void kernel_launch(void* const* d_in, const int* in_sizes, int n_in, void* d_out, int out_size, void* d_ws, size_t ws_size, hipStream_t stream) {
    static int grid = 0;
    if (grid == 0) {
        if (n_in != 23 || in_sizes[0] != ML * DM || out_size != ML * DM || ws_size < WS_END) {
            fprintf(stderr, "kernel_launch: unexpected shapes: n_in %d in0 %d out %d ws %zu (need %zu)\n", n_in, n_in > 0 ? in_sizes[0] : -1, out_size, ws_size, (size_t)WS_END); grid = -1; return; }
        int dev = 0, cus = 0, per_cu = 0;
        (void)hipGetDevice(&dev); (void)hipDeviceGetAttribute(&cus, hipDeviceAttributeMultiprocessorCount, dev);
        if (hipFuncSetAttribute((const void*)mk_fwd, hipFuncAttributeMaxDynamicSharedMemorySize, LDS_BYTES) != hipSuccess) { fprintf(stderr, "kernel_launch: hipFuncSetAttribute failed\n"); grid = -1; return; }
        if (hipOccupancyMaxActiveBlocksPerMultiprocessor(&per_cu, (const void*)mk_fwd, 512, LDS_BYTES) != hipSuccess || per_cu < 1) { fprintf(stderr, "kernel_launch: occupancy query gave %d\n", per_cu); per_cu = 1; }
        (void)hipGetLastError();
        grid = cus * per_cu;
    }
    if (grid < 0) return;
    (void)hipMemsetAsync((char*)d_ws + WS_CTL, 0, 32768, stream);
    Args a{};
    for (int i = 0; i < 23; ++i) a.in[i] = (const float*)d_in[i];
    a.out = (float*)d_out; a.ws = (unsigned char*)d_ws;
#if ONE_LAUNCH
    a.ph_lo = 0; a.ph_hi = N_PHASES;
    void* args[] = {&a};
    hipError_t e = hipLaunchCooperativeKernel((const void*)mk_fwd, dim3(grid), dim3(512), args, LDS_BYTES, stream);
    if (e != hipSuccess) fprintf(stderr, "kernel_launch: cooperative launch failed: %s (grid %d)\n", hipGetErrorString(e), grid);
#else
    for (int ph = 0; ph < N_PHASES; ++ph) { a.ph_lo = ph; a.ph_hi = ph + 1; hipLaunchKernelGGL(mk_fwd, dim3(grid), dim3(512), LDS_BYTES, stream, a); }
#endif
}
```

```cpp
#include <hip/hip_runtime.h>
#include <hip/hip_cooperative_groups.h>
#include <cstdio>
#include <cstdint>
namespace cg = cooperative_groups;
#ifndef ONE_LAUNCH
#define ONE_LAUNCH 1
#endif
#ifndef EN_F
#define EN_F 1
#endif
#ifndef EN_D
#define EN_D 1
#endif
#ifndef EN_N
#define EN_N 1
#endif
#ifndef EN_S
#define EN_S 1
#endif
#ifndef EN_P
#define EN_P 1
#endif
#ifndef EN_I
#define EN_I 1
#endif
#ifndef EN_R
#define EN_R 1
#endif
#ifndef EN_1
#define EN_1 1
#endif
#ifndef PROBE_S
#define PROBE_S -1
#endif
#ifndef PROBE_KIND
#define PROBE_KIND -1
#endif
#ifndef PROBE_P0
#define PROBE_P0 0
#endif
#ifndef PROBE_SYNC
#define PROBE_SYNC 0
#endif
namespace pg8 {
#define PG8_LAS __attribute__((address_space(3)))
typedef unsigned short bf16_t;
typedef short bf16x8 __attribute__((ext_vector_type(8)));
typedef float f32x4 __attribute__((ext_vector_type(4)));
typedef unsigned u32x4 __attribute__((ext_vector_type(4)));
constexpr int BM = 256, BK = 64, HALF = 128, HTB = HALF * BK * 2  , STAGE_BYTES = 8 * HTB, NXCD = 8, WGM = 8;

__host__ __device__ __forceinline__ int lds_byte(int r, int c) { const int st = (r >> 4) * 2 + (c >> 5), rr = r & 15, cc = c & 31, ob = rr * 64 + cc * 2; return st * 1024 + (ob ^ (((ob >> 9) & 1) << 5)); }
__host__ __device__ __forceinline__ void stage_rc(int b, int& R, int& C) { const int st = b / 1024, sb = b % 1024, swz = sb ^ (((sb >> 9) & 1) << 5); R = (st >> 1) * 16 + swz / 64; C = (st & 1) * 32 + (swz % 64) / 2; }
__host__ __device__ __forceinline__ int perm32(int rho) { const int n = rho >> 4, i = rho & 15; return 8 * (i >> 2) + 4 * n + (i & 3); }

struct Unit { int pm, pn, ko; };
struct Gemm { const bf16_t* A; const bf16_t* Bt; int M, N, K, ld; };

struct StaticOrder {
    int nM, nN, nwg, G, c;
    __host__ __device__ void init(int M, int N, int G_, int c_) { nM = M / BM; nN = N / BM; nwg = nM * nN; G = G_; c = c_; }
    __host__ __device__ bool next(int i, Unit& u) const {
        const long L = (long)i * G + c; if (L >= nwg) return false;
        int wgid = (int)L; { const int q = nwg / NXCD, r = nwg % NXCD, xcd = wgid % NXCD, off = wgid / NXCD; wgid = (xcd < r ? xcd * (q + 1) : r * (q + 1) + (xcd - r) * q) + off; }
        const int nig = WGM * nN, gid = wgid / nig, fm = gid * WGM, gsz = (nM - fm) < WGM ? (nM - fm) : WGM;
        u.pm = fm + ((wgid % nig) % gsz); u.pn = (wgid % nig) / gsz; u.ko = 0; return true;
    }
    __device__ __forceinline__ void a_ready(const Unit&) const {}
    __device__ __forceinline__ void done(const Unit&) const {}
};

template <class Epi, class Sched, bool ALIGN_EPI = false, bool SP2 = false>
__device__ __forceinline__ void gemm_phase(PG8_LAS unsigned char* lds, const Gemm g, const Sched& S, const Epi& E, const int tid) {
    const int wid = __builtin_amdgcn_readfirstlane(tid >> 6), lane = tid & 63, wr = wid >> 2, wc = wid & 3, fr = lane & 15, fq = lane >> 4;
    const int K = g.ld ? g.ld : g.K, nt = g.K / BK;
    unsigned voffA[2], voffB[2];
#pragma unroll
    for (int i = 0; i < 2; ++i) { int R, C; stage_rc(tid * 16 + i * 8192, R, C); const int Rb = Epi::PERM ? ((R & ~31) + perm32(R & 31)) : R;
        voffA[i] = (unsigned)(R * K + C) * 2u; voffB[i] = (unsigned)(Rb * K + C) * 2u; }
    const size_t kstep = (size_t)(BK * 2);
    const size_t hstep = (size_t)HALF * K * 2;
    const size_t tstep = 2 * hstep;
    const unsigned ldsw = (unsigned)wid * 1024u;
    const int aoff = lds_byte(wr * 64 + fr, fq * 8), boff = lds_byte(wc * 32 + fr, fq * 8);
#define PG8_SA(b, h) (((b) * 2 + (h)) * HTB)
#define PG8_SB(b, h) ((4 + (b) * 2 + (h)) * HTB)
#define PG8_STAGE(bufoff, gbase, voff) do { _Pragma("unroll") for (int _i = 0; _i < 2; ++_i) \
        __builtin_amdgcn_global_load_lds((const unsigned*)((const char*)(gbase) + (voff)[_i]), (PG8_LAS unsigned*)(lds + (bufoff) + ldsw + _i * 8192), 16, 0, 0); } while (0)
#define PG8_LDA(dst, b, h) do { _Pragma("unroll") for (int m = 0; m < 4; ++m) _Pragma("unroll") for (int k = 0; k < 2; ++k) dst[m][k] = *(const PG8_LAS bf16x8*)(lds + PG8_SA(b, h) + aoff + m * 2048 + k * 1024); } while (0)
#define PG8_LDB(dst, b, h) do { _Pragma("unroll") for (int n = 0; n < 2; ++n) _Pragma("unroll") for (int k = 0; k < 2; ++k) dst[n][k] = *(const PG8_LAS bf16x8*)(lds + PG8_SB(b, h) + boff + n * 2048 + k * 1024); } while (0)
#define PG8_MMA(ai, bj, At, Bt) do { __builtin_amdgcn_s_setprio(1); _Pragma("unroll") for (int m = 0; m < 4; ++m) _Pragma("unroll") for (int n = 0; n < 2; ++n) _Pragma("unroll") for (int k = 0; k < 2; ++k) \
        acc[ai][bj][m][n] = __builtin_amdgcn_mfma_f32_16x16x32_bf16(Bt[n][k], At[m][k], acc[ai][bj][m][n], 0, 0, 0); __builtin_amdgcn_s_setprio(0); } while (0)
#define PG8_WAIT_V(n) asm volatile("s_waitcnt vmcnt(" #n ")" ::: "memory")
#define PG8_WAIT_L(n) asm volatile("s_waitcnt lgkmcnt(" #n ")" ::: "memory")
#define PG8_BAR __builtin_amdgcn_s_barrier()
#define PG8_SCHED __builtin_amdgcn_sched_barrier(0)
    Unit cur, nxt; int ui = 0;
    if (!S.next(0, cur)) return;
    f32x4 acc[2][2][4][2];
#pragma unroll
    for (int a = 0; a < 2; ++a)
#pragma unroll
        for (int b = 0; b < 2; ++b)
#pragma unroll
            for (int m = 0; m < 4; ++m)
#pragma unroll
                for (int n = 0; n < 2; ++n) acc[a][b][m][n] = (f32x4){0.f, 0.f, 0.f, 0.f};
    bf16x8 At[4][2], B0[2][2], B1[2][2];
    const char* cA = (const char*)g.A + (size_t)cur.pm * tstep + cur.ko; const char* cB = (const char*)g.Bt + (size_t)cur.pn * tstep + cur.ko;
    S.a_ready(cur);
    if constexpr (SP2) {
        PG8_STAGE(PG8_SB(0, 0), cB, voffB); PG8_STAGE(PG8_SB(0, 1), cB + hstep, voffB); PG8_STAGE(PG8_SA(0, 0), cA, voffA); PG8_STAGE(PG8_SA(0, 1), cA + hstep, voffA);
        if (wr == 1) PG8_BAR;
        PG8_WAIT_V(2); PG8_BAR;
        PG8_STAGE(PG8_SB(1, 0), cB + kstep, voffB); PG8_STAGE(PG8_SA(1, 0), cA + kstep, voffA); PG8_STAGE(PG8_SB(1, 1), cB + hstep + kstep, voffB);
        PG8_WAIT_V(6); PG8_BAR;
    } else {
        PG8_STAGE(PG8_SB(0, 0), cB, voffB); PG8_STAGE(PG8_SA(0, 0), cA, voffA); PG8_STAGE(PG8_SB(0, 1), cB + hstep, voffB); PG8_STAGE(PG8_SA(0, 1), cA + hstep, voffA);
        if (wr == 1) PG8_BAR;
        PG8_WAIT_V(4); PG8_BAR;
        PG8_STAGE(PG8_SB(1, 0), cB + kstep, voffB); PG8_STAGE(PG8_SA(1, 0), cA + kstep, voffA); PG8_STAGE(PG8_SB(1, 1), cB + hstep + kstep, voffB);
        PG8_WAIT_V(6); PG8_BAR;
    }
    for (;;) {
        const bool has_next = S.next(ui + 1, nxt);
        const char* nA = has_next ? (const char*)g.A + (size_t)nxt.pm * tstep + nxt.ko : cA; const char* nB = has_next ? (const char*)g.Bt + (size_t)nxt.pn * tstep + nxt.ko : cB;
        for (int t = 0; t < nt; t += 2) {
            const bool last = (t == nt - 2);
            const char* a1 = cA + (size_t)(t + 1) * kstep;
            const char* a2 = last ? nA : cA + (size_t)(t + 2) * kstep; const char* b2 = last ? nB : cB + (size_t)(t + 2) * kstep;
            const char* a3 = a2 + kstep; const char* b3 = b2 + kstep;
            if (last && has_next) S.a_ready(nxt);
            if constexpr (SP2) {
            PG8_LDB(B0, 0, 0); PG8_LDB(B1, 0, 1); PG8_SCHED; PG8_LDA(At, 0, 0); PG8_STAGE(PG8_SA(1, 1), a1 + hstep, voffA);
            PG8_WAIT_V(8); PG8_WAIT_L(0); PG8_BAR; PG8_MMA(0, 0, At, B0); PG8_MMA(0, 1, At, B1); PG8_BAR; PG8_SCHED;
            PG8_LDA(At, 0, 1); PG8_STAGE(PG8_SB(0, 0), b2, voffB); PG8_STAGE(PG8_SB(0, 1), b2 + hstep, voffB); PG8_STAGE(PG8_SA(0, 0), a2, voffA);
            PG8_WAIT_V(8); PG8_WAIT_L(0); PG8_BAR; PG8_MMA(1, 0, At, B0); PG8_MMA(1, 1, At, B1); PG8_BAR; PG8_SCHED;
            PG8_LDB(B0, 1, 0); PG8_LDB(B1, 1, 1); PG8_SCHED; PG8_LDA(At, 1, 0); PG8_STAGE(PG8_SA(0, 1), a2 + hstep, voffA);
            PG8_WAIT_V(8); PG8_WAIT_L(0); PG8_BAR; PG8_MMA(0, 0, At, B0); PG8_MMA(0, 1, At, B1); PG8_BAR; PG8_SCHED;
            PG8_LDA(At, 1, 1); PG8_STAGE(PG8_SB(1, 0), b3, voffB); PG8_STAGE(PG8_SB(1, 1), b3 + hstep, voffB); PG8_STAGE(PG8_SA(1, 0), a3, voffA);
            PG8_WAIT_V(8); PG8_WAIT_L(0); PG8_BAR; PG8_MMA(1, 0, At, B0); PG8_MMA(1, 1, At, B1); PG8_BAR; PG8_SCHED;
            } else {
            PG8_LDB(B0, 0, 0); PG8_SCHED; PG8_LDA(At, 0, 0); PG8_STAGE(PG8_SA(1, 1), a1 + hstep, voffA);
            PG8_WAIT_L(8); PG8_BAR; PG8_WAIT_L(0); PG8_MMA(0, 0, At, B0); PG8_BAR; PG8_SCHED;
            PG8_LDB(B1, 0, 1); PG8_STAGE(PG8_SB(0, 0), b2, voffB);
            PG8_BAR; PG8_WAIT_L(0); PG8_MMA(0, 1, At, B1); PG8_BAR;
            PG8_LDA(At, 0, 1); PG8_STAGE(PG8_SA(0, 0), a2, voffA);
            PG8_BAR; PG8_WAIT_L(0); PG8_MMA(1, 0, At, B0); PG8_BAR; PG8_SCHED;
            PG8_STAGE(PG8_SB(0, 1), b2 + hstep, voffB);
            PG8_WAIT_V(6); PG8_BAR; PG8_MMA(1, 1, At, B1); PG8_BAR;
            PG8_LDB(B0, 1, 0); PG8_SCHED; PG8_LDA(At, 1, 0); PG8_STAGE(PG8_SA(0, 1), a2 + hstep, voffA);
            PG8_WAIT_L(8); PG8_BAR; PG8_WAIT_L(0); PG8_MMA(0, 0, At, B0); PG8_BAR; PG8_SCHED;
            PG8_LDB(B1, 1, 1); PG8_STAGE(PG8_SB(1, 0), b3, voffB);
            PG8_BAR; PG8_WAIT_L(0); PG8_MMA(0, 1, At, B1); PG8_BAR;
            PG8_LDA(At, 1, 1); PG8_STAGE(PG8_SA(1, 0), a3, voffA);
            PG8_BAR; PG8_WAIT_L(0); PG8_MMA(1, 0, At, B0); PG8_BAR; PG8_SCHED;
            PG8_STAGE(PG8_SB(1, 1), b3 + hstep, voffB);
            PG8_WAIT_V(6); PG8_BAR; PG8_MMA(1, 1, At, B1); PG8_BAR;
            }
        }
        if constexpr (ALIGN_EPI) { if (wr == 0) PG8_BAR; }
        if constexpr (!Epi::AFTER_DRAIN) { E(acc, cur, wr, wc, fr, fq); S.done(cur); }
        if (!has_next) break;
#pragma unroll
        for (int a = 0; a < 2; ++a)
#pragma unroll
            for (int b = 0; b < 2; ++b)
#pragma unroll
                for (int m = 0; m < 4; ++m)
#pragma unroll
                    for (int n = 0; n < 2; ++n) acc[a][b][m][n] = (f32x4){0.f, 0.f, 0.f, 0.f};
        cur = nxt; cA = nA; cB = nB; ++ui;
        if constexpr (ALIGN_EPI) { if (wr == 1) PG8_BAR; }
    }
    PG8_WAIT_V(0);
    if constexpr (!ALIGN_EPI) { if (wr == 0) PG8_BAR; }
    PG8_BAR;
    if constexpr (Epi::AFTER_DRAIN) { E.fused(acc, cur, wr, wc, fr, fq, lds, wid, lane); S.done(cur); }
#undef PG8_SA
#undef PG8_SB
#undef PG8_STAGE
#undef PG8_LDA
#undef PG8_LDB
#undef PG8_MMA
#undef PG8_WAIT_V
#undef PG8_WAIT_L
#undef PG8_BAR
#undef PG8_SCHED
}
}
#define DI __device__ __forceinline__
#define LAS __attribute__((address_space(3)))
typedef unsigned short bf16_t;
typedef short bf16x8 __attribute__((ext_vector_type(8)));
typedef short s16x4 __attribute__((ext_vector_type(4)));
typedef float f32x4 __attribute__((ext_vector_type(4)));
typedef float f32x2 __attribute__((ext_vector_type(2)));
typedef float f32x16 __attribute__((ext_vector_type(16)));
typedef unsigned u32x4 __attribute__((ext_vector_type(4)));
typedef unsigned u32x2 __attribute__((ext_vector_type(2)));
typedef __bf16 bf2_t __attribute__((ext_vector_type(2)));
DI unsigned pk2(float lo, float hi) { f32x2 v = {lo, hi}; return __builtin_bit_cast(unsigned, __builtin_convertvector(v, bf2_t)); }
DI bf16_t f2bf(float x) { return (bf16_t)(pk2(x, 0.f) & 0xffffu); }
DI float bf2f(unsigned v) { return __builtin_bit_cast(float, v << 16); }
#define MFMA32(a, b, c) __builtin_amdgcn_mfma_f32_32x32x16_bf16((a), (b), (c), 0, 0, 0)
DI float ex2(float x) { return __builtin_amdgcn_exp2f(x); }
DI float xor32(float v) { return __shfl_xor(v, 32); }

constexpr int DM = 1024, NB = 8, SEQ = 4096, DEPTH = 4, CTX = 256, DFF = 4096;
constexpr int ML = NB * SEQ, MC = NB * CTX, MT = ML + MC, NIN = 2560, KV = SEQ + CTX;
constexpr float LOG2E = 1.4426950408889634f;
constexpr size_t MiB = 1u << 20;
constexpr size_t WS_CTL = 0, WS_LAM = 32768, WS_MOD = 1 * MiB, WS_CSC = 2 * MiB, WS_WIN = 4 * MiB, WS_WOUT = 24 * MiB, WS_WFF1 = 32 * MiB,
                 WS_WFF2 = 64 * MiB, WS_CS = 96 * MiB, WS_H = 160 * MiB, WS_CX = 228 * MiB, WS_U = 236 * MiB;
constexpr size_t WS_PQT = WS_U, WS_PQTC = WS_U + 32 * MiB, WS_NAQ = WS_U + 34 * MiB, WS_NAK = WS_U + 51 * MiB, WS_SGU = WS_U + 68 * MiB,
                 WS_SGV = WS_U + 85 * MiB, WS_DFQ = WS_U + 102 * MiB, WS_DFK = WS_U + 119 * MiB, WS_NAVT = WS_U + 136 * MiB, WS_DFVT = WS_U + 153 * MiB;
constexpr size_t WS_END = WS_U + 272 * MiB;
constexpr size_t WS_SGW = 2 * MiB + 256 * 1024;
constexpr size_t WS_PB = WS_CS + 1 * MiB;
constexpr int LDS_BYTES = 147456, MISC_OFF = 131072, ROPE_OFF = MISC_OFF + 1024, RPB_OFF = MISC_OFF + 5120;

struct Args { const float* in[23]; float* out; unsigned char* ws; int ph_lo, ph_hi; };

DI void transpose_tile(const Args& A, int l, int r, LAS unsigned char* lds, const int tid) {
    const int lane = tid & 63, wid = __builtin_amdgcn_readfirstlane(tid >> 6);
    unsigned char* ws = A.ws;
    LAS float* big = (LAS float*)(lds + 53248);
    const float* src; bf16_t* dst; int K, N, kt, nt;
    if (r < 128) { K = 1024; N = 2304; kt = r >> 3; nt = r & 7; src = A.in[8] + (size_t)l * 1024 * 2304 + 256; dst = (bf16_t*)(ws + WS_WIN) + (size_t)l * NIN * 1024 + 512 * 1024; }
    else if (r < 192) { r -= 128; K = 1024; N = 1024; kt = r >> 2; nt = r & 3; src = A.in[9] + (size_t)l * 1024 * 1024; dst = (bf16_t*)(ws + WS_WOUT) + (size_t)l * 1024 * 1024; }
    else if (r < 448) { r -= 192; K = 1024; N = 4096; kt = r >> 4; nt = r & 15; src = A.in[20] + (size_t)l * 1024 * 4096; dst = (bf16_t*)(ws + WS_WFF1) + (size_t)l * 4096 * 1024; }
    else { r -= 448; K = 4096; N = 1024; kt = r >> 2; nt = r & 3; src = A.in[21] + (size_t)l * 4096 * 1024; dst = (bf16_t*)(ws + WS_WFF2) + (size_t)l * 1024 * 4096; }
    float v[32];
    const float* sp = src + (size_t)(kt * 64 + (tid >> 6)) * N + nt * 256 + lane;
#pragma unroll
    for (int i = 0; i < 8; ++i)
#pragma unroll
        for (int j = 0; j < 4; ++j) v[i * 4 + j] = __builtin_nontemporal_load(sp + (size_t)(8 * i) * N + 64 * j);
    __syncthreads();
#pragma unroll
    for (int i = 0; i < 8; ++i)
#pragma unroll
        for (int j = 0; j < 4; ++j) big[(wid + 8 * i) * 257 + 64 * j + lane] = v[i * 4 + j];
    __syncthreads();
#pragma unroll 4
    for (int i = 0; i < 32; ++i) { const int nn = wid + 8 * i; dst[(size_t)(nt * 256 + nn) * K + kt * 64 + lane] = f2bf(big[lane * 257 + nn]); }
}

DI void phase_prologue(const Args& A, LAS unsigned char* lds, const int tid, const int parts = 15) {
    const int lane = tid & 63, wid = __builtin_amdgcn_readfirstlane(tid >> 6);
    unsigned char* ws = A.ws;
    LAS float* silu_t = (LAS float*)lds;
    LAS float* cos_t = (LAS float*)(lds + 36864);
    LAS float* tile = (LAS float*)(lds + 53248);
    LAS float* red = (LAS float*)(lds + 69888);
    for (int i = tid; i < 9 * 1024; i += 512) { const int r = i >> 10, k = i & 1023; const float v = r < 8 ? A.in[1][r * 1024 + k] : A.in[3][k]; silu_t[i] = v / (1.f + expf(-v)); }
    for (int i = tid; i < 4096; i += 512) cos_t[i] = cospif((float)i * (1.f / 2048.f));
    LAS float* c64 = (LAS float*)(lds + 122880);
    if (tid < 64) { c64[tid] = cospif((float)tid * (1.f / 32.f)); c64[64 + tid] = sinpif((float)tid * (1.f / 32.f)); }
    if (blockIdx.x == 0 && tid < DEPTH) {
        const int l = tid; float s1 = 0.f, s2 = 0.f;
        for (int i = 0; i < 32; ++i) { s1 += A.in[15][l * 32 + i] * A.in[16][l * 32 + i]; s2 += A.in[17][l * 32 + i] * A.in[18][l * 32 + i]; }
        const float lam_init = 0.8f - 0.6f * expf(-0.3f * (float)l);
        float* lt = (float*)(ws + WS_LAM); lt[2 * l] = expf(s1) - expf(s2) + lam_init; lt[2 * l + 1] = 1.f - lam_init;
    }
    __syncthreads();
    {
        const float* src = A.in[13]; bf16_t* dst = (bf16_t*)(ws + WS_SGW);
        for (int i = blockIdx.x * 512 + tid; i < DEPTH * 4 * 128 * 128 / 2; i += gridDim.x * 512) ((unsigned*)dst)[i] = pk2(src[2 * i], src[2 * i + 1]);
    }
    {
        const f32x4* src = (const f32x4*)A.in[2]; f32x4* dst = (f32x4*)(ws + WS_CX);
        for (int i = blockIdx.x * 512 + tid; i < MC * DM / 4; i += gridDim.x * 512) dst[i] = src[i];
    }
    bf16_t* CS = (bf16_t*)(ws + WS_CS);
    if (parts & 1)
    for (int rr = blockIdx.x; rr < 512; rr += gridDim.x) {
        const int pm = rr >> 8, row = rr & 255, cs = row >> 7, k1 = 128 * pm + (row & 127), pq = tid >> 8, n1 = tid & 255;
        const int t = ((n1 * k1) & 255) * 16;
        const float cv = cos_t[t], sv = cos_t[(t + 3072) & 4095];
        CS[(size_t)rr * 512 + tid] = f2bf(cs == 0 ? (pq == 0 ? cv : sv) : (pq == 0 ? -sv : cv));
    }
    bf16_t* CSc = (bf16_t*)(ws + WS_CSC);
    for (int k = blockIdx.x; k < 256; k += gridDim.x) { const int j = tid, jj = j & 255; int t = ((k * jj) & 255) * 16; if (j >= 256) t = (t + 3072) & 4095; CSc[k * 512 + j] = f2bf(cos_t[t]); }
    if (parts & 2)
    for (int it = blockIdx.x; it < 256; it += gridDim.x) {
        const int l = it >> 6, h = (it >> 4) & 3, kb = it & 15;
        const float* src = A.in[8] + (size_t)l * 1024 * 2304 + (size_t)(kb * 64) * 2304 + h * 64;
        __syncthreads();
#pragma unroll
        for (int i = 0; i < 8; ++i) { const int kk = wid + 8 * i; tile[kk * 65 + lane] = src[(size_t)kk * 2304 + lane]; }
        __syncthreads();
        bf16_t* dst = (bf16_t*)(ws + WS_WIN) + (size_t)l * NIN * 1024;
        const int m = lane;
#pragma unroll 1
        for (int i = 0; i < 8; ++i) {
            const int kk = wid + 8 * i; float P = 0.f, Q = 0.f;
#pragma unroll 4
            for (int c = 0; c < 64; ++c) { const float w = tile[kk * 65 + c]; const int t = (c * m) & 63; P += w * c64[t]; Q += w * c64[64 + t]; }
            dst[(size_t)(h * 64 + m) * 1024 + kb * 64 + kk] = f2bf(P); dst[(size_t)(256 + h * 64 + m) * 1024 + kb * 64 + kk] = f2bf(-Q);
        }
    }
    if (parts & 4)
    for (int it = blockIdx.x; it < 704; it += gridDim.x) transpose_tile(A, 0, it, lds, tid);
    float* MOD = (float*)(ws + WS_MOD);
    if (parts & 8)
    for (int it = blockIdx.x; it < 4 * 192; it += gridDim.x) {
        const int l = it / 192, nb = it % 192, cl = lane & 31, kp = lane >> 5;
        const float* w = A.in[4] + (size_t)l * 1024 * 6144 + nb * 32 + cl;
        float acc[9];
#pragma unroll
        for (int r = 0; r < 9; ++r) acc[r] = 0.f;
#pragma unroll 16
        for (int k = wid * 128 + kp; k < wid * 128 + 128; k += 2) {
            const float wv = __builtin_nontemporal_load(w + (size_t)k * 6144);
#pragma unroll
            for (int r = 0; r < 9; ++r) acc[r] += silu_t[r * 1024 + k] * wv;
        }
        __syncthreads();
#pragma unroll
        for (int r = 0; r < 9; ++r) red[(wid * 9 + r) * 64 + lane] = acc[r];
        __syncthreads();
        for (int i = tid; i < 9 * 32; i += 512) {
            const int r = i >> 5, nn = i & 31; float sm = 0.f;
            for (int w8 = 0; w8 < 8; ++w8) sm += red[(w8 * 9 + r) * 64 + nn] + red[(w8 * 9 + r) * 64 + 32 + nn];
            MOD[(size_t)(l * 9 + r) * 6144 + nb * 32 + nn] = sm + A.in[5][l * 6144 + nb * 32 + nn];
        }
    }
}

DI float wave_sum(float v) {
#pragma unroll
    for (int o = 32; o > 0; o >>= 1) v += __shfl_xor(v, o);
    return v;
}
DI void phase_norm(const Args& A, int l, int which, int nrows, const float* srcL, float* srcC, const float* pgate, const int tid) {
    const int lane = tid & 63, wid = tid >> 6;
    const float* g = A.in[which ? 7 : 6] + l * 1024;
    const float* mod = (const float*)(A.ws + WS_MOD) + (size_t)l * 9 * 6144;
    bf16_t* H = (bf16_t*)(A.ws + WS_H);
    const int stride = gridDim.x * 8;
    constexpr int NR = 4;
    for (int row0 = blockIdx.x * 8 + wid; row0 < nrows; row0 += NR * stride) {
        f32x4 v[NR][4]; float ss[NR];
#pragma unroll
        for (int u = 0; u < NR; ++u) {
            const int row = min(row0 + u * stride, nrows - 1);
            const float* src = row < ML ? srcL + (size_t)row * 1024 : srcC + (size_t)(row - ML) * 1024;
            ss[u] = 0.f;
#pragma unroll
            for (int i = 0; i < 4; ++i) v[u][i] = __builtin_nontemporal_load((const f32x4*)(src + i * 256 + lane * 4));
            if (pgate != nullptr && row >= ML) {
                const float* pb = (const float*)(A.ws + WS_PB) + (size_t)(row - ML) * 1024;
#pragma unroll
                for (int i = 0; i < 4; ++i) {
                    const int k = i * 256 + lane * 4;
                    const f32x4 p = *(const f32x4*)(pb + k) + *(const f32x4*)(pb + (size_t)MC * 1024 + k) + *(const f32x4*)(pb + (size_t)2 * MC * 1024 + k) + *(const f32x4*)(pb + (size_t)3 * MC * 1024 + k);
                    v[u][i] = v[u][i] + *(const f32x4*)(pgate + k) * p;
                    if (row0 + u * stride < nrows) *(f32x4*)(srcC + (size_t)(row - ML) * 1024 + k) = v[u][i];
                }
            }
#pragma unroll
            for (int i = 0; i < 4; ++i) ss[u] += v[u][i].x * v[u][i].x + v[u][i].y * v[u][i].y + v[u][i].z * v[u][i].z + v[u][i].w * v[u][i].w;
        }
#pragma unroll
        for (int u = 0; u < NR; ++u) {
            const int row = row0 + u * stride;
            if (row < nrows) {
                const int bidx = row < ML ? (row >> 12) : 8;
                const float* sh = mod + bidx * 6144 + (which ? 3 : 0) * 1024; const float* sc = sh + 1024;
                const float r = rsqrtf(wave_sum(ss[u]) * (1.f / 1024.f) + 1e-6f);
#pragma unroll
                for (int i = 0; i < 4; ++i) {
                    const int k = i * 256 + lane * 4;
                    const f32x4 gv = *(const f32x4*)(g + k), sv = *(const f32x4*)(sc + k), hv = *(const f32x4*)(sh + k);
                    const f32x4 y = v[u][i] * r * gv * (1.f + sv) + hv;
                    u32x2 o; o.x = pk2(y.x, y.y); o.y = pk2(y.z, y.w);
                    *(u32x2*)(H + (size_t)row * 1024 + k) = o;
                }
            }
        }
    }
}
DI void phase_final(const Args& A, const int tid) {
    const int lane = tid & 63, wid = tid >> 6;
    const float* g = A.in[22];
    for (int row = blockIdx.x * 8 + wid; row < ML; row += gridDim.x * 8) {
        float* p = A.out + (size_t)row * 1024;
        f32x4 v[4]; float ss = 0.f;
#pragma unroll
        for (int i = 0; i < 4; ++i) { v[i] = __builtin_nontemporal_load((const f32x4*)(p + i * 256 + lane * 4)); ss += v[i].x * v[i].x + v[i].y * v[i].y + v[i].z * v[i].z + v[i].w * v[i].w; }
        ss = wave_sum(ss);
        const float r = rsqrtf(ss * (1.f / 1024.f) + 1e-6f);
#pragma unroll
        for (int i = 0; i < 4; ++i) { const int k = i * 256 + lane * 4; __builtin_nontemporal_store(v[i] * r * *(const f32x4*)(g + k), (f32x4*)(p + k)); }
    }
}
struct OneUnit {
    pg8::Unit u;
    DI bool next(int i, pg8::Unit& o) const { if (i) return false; o = u; return true; }
    DI void a_ready(const pg8::Unit&) const {}
    DI void done(const pg8::Unit&) const {}
};
DI float gelu_tanh(float x) { const float y = 0.7978845608028654f * (x + 0.044715f * x * x * x); return x * __builtin_amdgcn_rcpf(1.f + ex2(-2.f * LOG2E * y)); }

struct EpiIn {
    static constexpr bool PERM = true, AFTER_DRAIN = false;
    unsigned char* ws; const LAS float* rope;
    DI void operator()(const pg8::f32x4 (&acc)[2][2][4][2], const pg8::Unit& u, int wr, int wc, int fr, int fq) const {
        const int pm = u.pm, pn = u.pn; const bool lat = pm < 128; const int b = lat ? (pm >> 4) : (pm - 128);
        const int r0 = pm * 256 + wr * 64 + fr, c0 = wc * 32 + 8 * fq;
        const int p0 = lat ? (r0 & 4095) : (r0 - ML - b * 256);
        if (pn <= 1 || pn == 4 || pn == 9) {
            bf16_t* base; unsigned rs; int poff;
            if (pn <= 1 && lat) {
                bf16_t* zt = (bf16_t*)(ws + WS_PQT);
                const int n2 = fr, n1b = (pm & 15) * 16 + wr * 4;
#pragma unroll
                for (int ai = 0; ai < 2; ++ai)
#pragma unroll
                    for (int bj = 0; bj < 2; ++bj) {
                        const int hmhi = 2 * wc + 8 * bj + (fq >> 1);
#pragma unroll
                        for (int e = 0; e < 8; ++e) {
                            const int hmlo = 8 * (fq & 1) + e;
                            const int c = 128 * (n2 >> 3) + 4 * ((n2 >> 2) & 1) + (n2 & 3) + 32 * (hmlo >> 2) + 8 * (hmlo & 3);
                            u32x2 w;
                            w.x = pk2(acc[ai][bj][0][e >> 2][e & 3], acc[ai][bj][1][e >> 2][e & 3]); w.y = pk2(acc[ai][bj][2][e >> 2][e & 3], acc[ai][bj][3][e >> 2][e & 3]);
                            *(u32x2*)(zt + ((unsigned)((b * 16 + hmhi) * 256 + c) * 512u + (unsigned)(pn * 256 + n1b + 8 * ai))) = w;
                        }
                        __builtin_amdgcn_sched_barrier(0);
                    }
                return;
            }
            if (pn <= 1) { base = (bf16_t*)(ws + WS_PQTC) + (size_t)b * 256 * 512; rs = 512; poff = 256 * pn; }
            else { base = (bf16_t*)(ws + (pn == 4 ? WS_NAVT : WS_DFVT)) + (size_t)b * 256 * KV; rs = KV; poff = lat ? 0 : 4096; }
#pragma unroll
            for (int ai = 0; ai < 2; ++ai)
#pragma unroll
                for (int m = 0; m < 4; ++m) {
                    const int pos = p0 + 128 * ai + 16 * m + poff;
#pragma unroll
                    for (int bj = 0; bj < 2; ++bj) {
                        const unsigned d = (unsigned)(c0 + 128 * bj) * rs + (unsigned)pos;
#pragma unroll
                        for (int e = 0; e < 8; ++e) base[d + (unsigned)e * rs] = f2bf(acc[ai][bj][m][e >> 2][e & 3]);
                    }
                    __builtin_amdgcn_sched_barrier(0);
                }
        } else {
            bf16_t* O; float sc = 1.f; int mode = 0;
            if (pn == 2) { O = (bf16_t*)(ws + WS_NAQ); sc = 0.125f * LOG2E; }
            else if (pn == 3) { O = (bf16_t*)(ws + WS_NAK); }
            else if (pn == 5) { O = (bf16_t*)(ws + WS_SGU); mode = 1; }
            else if (pn == 6) { O = (bf16_t*)(ws + WS_SGV); mode = 1; }
            else if (pn == 7) { O = (bf16_t*)(ws + WS_DFQ); sc = 0.17677669529663687f * LOG2E; mode = lat ? 2 : 0; }
            else { O = (bf16_t*)(ws + WS_DFK); mode = lat ? 2 : 0; }
#pragma unroll
            for (int ai = 0; ai < 2; ++ai)
#pragma unroll
                for (int m = 0; m < 4; ++m) {
                    const int row = r0 + 128 * ai + 16 * m, pos = p0 + 128 * ai + 16 * m;
#pragma unroll
                    for (int bj = 0; bj < 2; ++bj) {
                        float v[8];
#pragma unroll
                        for (int e = 0; e < 8; ++e) v[e] = acc[ai][bj][m][e >> 2][e & 3];
                        if (mode == 1) {
#pragma unroll
                            for (int e = 0; e < 8; ++e) v[e] = gelu_tanh(v[e]);
                        } else if (mode == 2) {
                            const int pa = (fq < 2) ? (pos >> 6) : (pos & 63);
                            const LAS float* tab = rope + pa * 16;
#pragma unroll
                            for (int e = 0; e < 8; ++e) {
                                const float pr = __shfl_xor(v[e], 16), cs = tab[2 * e], sn = tab[2 * e + 1];
                                v[e] = v[e] * cs + ((fq & 1) ? pr * sn : -pr * sn);
                            }
                        }
                        u32x4 w; w.x = pk2(v[0] * sc, v[1] * sc); w.y = pk2(v[2] * sc, v[3] * sc); w.z = pk2(v[4] * sc, v[5] * sc); w.w = pk2(v[6] * sc, v[7] * sc);
                        *(u32x4*)(O + ((unsigned)row * 256u + (unsigned)(c0 + 128 * bj))) = w;
                        __builtin_amdgcn_sched_barrier(0);
                    }
                }
        }
    }
};
struct EpiRes {
    static constexpr bool PERM = false, AFTER_DRAIN = false;
    const float* srcL; const float* srcC; float* dstL; float* dstC; const float* gate;
    DI void operator()(const pg8::f32x4 (&acc)[2][2][4][2], const pg8::Unit& u, int wr, int wc, int fr, int fq) const {
        const int pm = u.pm; const bool lat = pm < 128; const float* g = gate + (lat ? (pm >> 4) : 8) * 6144;
        const int row0 = pm * 256 + wr * 64 + fr, col0 = u.pn * 256 + wc * 32 + 4 * fq;
#pragma unroll
        for (int ai = 0; ai < 2; ++ai)
#pragma unroll
            for (int m = 0; m < 4; ++m) {
                const int row = row0 + 128 * ai + 16 * m;
                const float* s = lat ? srcL : srcC; float* d = lat ? dstL : dstC;
                const unsigned ro = (unsigned)(lat ? row : row - ML) * 1024u;
#pragma unroll
                for (int bj = 0; bj < 2; ++bj)
#pragma unroll
                    for (int n = 0; n < 2; ++n) {
                        const unsigned col = (unsigned)(col0 + 128 * bj + 16 * n);
                        const f32x4 xv = *(const f32x4*)(s + (ro + col)), gv = *(const f32x4*)(g + col);
                        *(f32x4*)(d + (ro + col)) = xv + gv * acc[ai][bj][m][n];
                    }
            }
    }
};
struct SplitOrder {
    int kshift, G, c;
    DI bool next(int i, pg8::Unit& u) const { const int p = i * G + c; if (p >= 128) return false; u.pm = 128 + (p >> 4); u.pn = (p >> 2) & 3; u.ko = (p & 3) << kshift; return true; }
    DI void a_ready(const pg8::Unit&) const {}
    DI void done(const pg8::Unit&) const {}
};
struct EpiPartial {
    static constexpr bool PERM = false, AFTER_DRAIN = false;
    float* PB; int kshift;
    DI void operator()(const pg8::f32x4 (&acc)[2][2][4][2], const pg8::Unit& u, int wr, int wc, int fr, int fq) const {
        float* base = PB + (size_t)(u.ko >> kshift) * MC * 1024;
        const int row0 = (u.pm - 128) * 256 + wr * 64 + fr, col0 = u.pn * 256 + wc * 32 + 4 * fq;
#pragma unroll
        for (int ai = 0; ai < 2; ++ai)
#pragma unroll
            for (int m = 0; m < 4; ++m)
#pragma unroll
                for (int bj = 0; bj < 2; ++bj)
#pragma unroll
                    for (int n = 0; n < 2; ++n)
                        *(f32x4*)(base + ((unsigned)(row0 + 128 * ai + 16 * m) * 1024u + (unsigned)(col0 + 128 * bj + 16 * n))) = acc[ai][bj][m][n];
    }
};
struct EpiFF1 {
    static constexpr bool PERM = true, AFTER_DRAIN = false;
    bf16_t* U;
    DI void operator()(const pg8::f32x4 (&acc)[2][2][4][2], const pg8::Unit& u, int wr, int wc, int fr, int fq) const {
        const int row0 = u.pm * 256 + wr * 64 + fr, col0 = u.pn * 256 + wc * 32 + 8 * fq;
#pragma unroll
        for (int ai = 0; ai < 2; ++ai)
#pragma unroll
            for (int m = 0; m < 4; ++m)
#pragma unroll
                for (int bj = 0; bj < 2; ++bj) {
                    f32x4 a0 = acc[ai][bj][m][0], a1 = acc[ai][bj][m][1];
                    a0 = __builtin_elementwise_max(a0, (f32x4){0.f, 0.f, 0.f, 0.f}); a1 = __builtin_elementwise_max(a1, (f32x4){0.f, 0.f, 0.f, 0.f});
                    a0 = a0 * a0; a1 = a1 * a1;
                    u32x4 w; w.x = pk2(a0[0], a0[1]); w.y = pk2(a0[2], a0[3]); w.z = pk2(a1[0], a1[1]); w.w = pk2(a1[2], a1[3]);
                    __builtin_nontemporal_store(w, (u32x4*)(U + ((unsigned)(row0 + 128 * ai + 16 * m) * 4096u + (unsigned)(col0 + 128 * bj))));
                }
    }
};
constexpr float C16[16] = {1.f, 0.92387953251f, 0.70710678119f, 0.38268343237f, 0.f, -0.38268343237f, -0.70710678119f, -0.92387953251f,
                           -1.f, -0.92387953251f, -0.70710678119f, -0.38268343237f, 0.f, 0.38268343237f, 0.70710678119f, 0.92387953251f};
constexpr float S16[16] = {0.f, 0.38268343237f, 0.70710678119f, 0.92387953251f, 1.f, 0.92387953251f, 0.70710678119f, 0.38268343237f,
                           0.f, -0.38268343237f, -0.70710678119f, -0.92387953251f, -1.f, -0.92387953251f, -0.70710678119f, -0.38268343237f};
struct EpiFour {
    static constexpr bool PERM = true, AFTER_DRAIN = false;
    bf16_t* Y; int rowbase, rpb; float scale; int kind;
    DI void operator()(const pg8::f32x4 (&acc)[2][2][4][2], const pg8::Unit& u, int wr, int wc, int fr, int fq) const {
        if (kind == 0) {
            const int b = u.pn >> 4, hm = 16 * (u.pn & 15) + 4 * wc + fq;
#pragma unroll
            for (int m = 0; m < 4; ++m) {
                const int k1 = 128 * u.pm + 64 * wr + 16 * m + fr;
                float zr[16], zi[16];
#pragma unroll
                for (int n2 = 0; n2 < 16; ++n2) {
                    const float tc = acc[0][n2 >> 3][m][(n2 >> 2) & 1][n2 & 3], ts = acc[1][n2 >> 3][m][(n2 >> 2) & 1][n2 & 3];
                    const float fr_ = (float)((n2 * k1) & 4095) * (1.f / 4096.f);
                    const float c = __builtin_amdgcn_cosf(fr_), sn = __builtin_amdgcn_sinf(fr_);
                    zr[n2] = tc * c + ts * sn; zi[n2] = tc * sn - ts * c;
                }
                bf16_t* yp = Y + ((unsigned)(b * 4096 + k1) * 1024u + (unsigned)hm);
#pragma unroll
                for (int k2 = 0; k2 < 16; ++k2) {
                    float o = 0.f;
#pragma unroll
                    for (int n2 = 0; n2 < 16; ++n2) {
                        const float cc = C16[(n2 * k2) & 15], sc = S16[(n2 * k2) & 15];
                        if (cc != 0.f) o += zr[n2] * cc;
                        if (sc != 0.f) o -= zi[n2] * sc;
                    }
                    yp[(unsigned)k2 * 256u * 1024u] = f2bf(o * (1.f / 512.f));
                }
                __builtin_amdgcn_sched_barrier(0);
            }
            return;
        }
        const int row0 = rowbase + u.pn * rpb + u.pm * 256 + wr * 64 + fr, col0 = wc * 32 + 8 * fq;
#pragma unroll
        for (int ai = 0; ai < 2; ++ai)
#pragma unroll
            for (int m = 0; m < 4; ++m)
#pragma unroll
                for (int bj = 0; bj < 2; ++bj) {
                    const f32x4 a0 = acc[ai][bj][m][0] * scale, a1 = acc[ai][bj][m][1] * scale;
                    u32x4 w; w.x = pk2(a0[0], a0[1]); w.y = pk2(a0[2], a0[3]); w.z = pk2(a1[0], a1[1]); w.w = pk2(a1[2], a1[3]);
                    *(u32x4*)(Y + ((unsigned)(row0 + 128 * ai + 16 * m) * 1024u + (unsigned)(col0 + 128 * bj))) = w;
                }
    }
};

DI bf16x8 ldg8(const bf16_t* p) { return *(const bf16x8*)p; }
DI bf16x8 ldv(const bf16_t* p) { const s16x4 lo = *(const s16x4*)p, hi = *(const s16x4*)(p + 8); return __builtin_shufflevector(lo, hi, 0, 1, 2, 3, 4, 5, 6, 7); }
DI f32x16 zero16() { f32x16 z; for (int i = 0; i < 16; ++i) z[i] = 0.f; return z; }
DI void softmax_step(f32x16& s, float& m, float& l, f32x16& Oa, f32x16& Ob, bf16x8& pa, bf16x8& pb) {
    float t = s[0];
#pragma unroll
    for (int i = 1; i < 16; ++i) t = fmaxf(t, s[i]);
    t = fmaxf(t, xor32(t));
    const float mn = fmaxf(m, t), al = ex2(m - mn); m = mn;
    float sum = 0.f;
#pragma unroll
    for (int i = 0; i < 16; ++i) { const float p = s[i] > -1e29f ? ex2(s[i] - mn) : 0.f; s[i] = p; sum += p; }
    l = l * al + sum; Oa = Oa * al; Ob = Ob * al;
    u32x4 a, b;
    a.x = pk2(s[0], s[1]); a.y = pk2(s[2], s[3]); a.z = pk2(s[4], s[5]); a.w = pk2(s[6], s[7]);
    b.x = pk2(s[8], s[9]); b.y = pk2(s[10], s[11]); b.z = pk2(s[12], s[13]); b.w = pk2(s[14], s[15]);
    pa = __builtin_bit_cast(bf16x8, a); pb = __builtin_bit_cast(bf16x8, b);
}

DI float exp_sum(const f32x16& sa, const f32x16& sb, f32x16& pa, f32x16& pb) {
    f32x2 s2 = {0.f, 0.f};
#pragma unroll
    for (int i = 0; i < 16; i += 2) {
        pa[i] = ex2(sa[i]); pa[i + 1] = ex2(sa[i + 1]); pb[i] = ex2(sb[i]); pb[i + 1] = ex2(sb[i + 1]);
        s2 += (f32x2){pa[i], pa[i + 1]}; s2 += (f32x2){pb[i], pb[i + 1]};
    }
    return s2.x + s2.y;
}
DI void smax64(f32x16& sa, f32x16& sb, float& m, float& l, f32x16& Oa, f32x16& Ob, const bool first, bf16x8 (&p)[4]) {
    f32x16 pa, pb;
    float sum = exp_sum(sa, sb, pa, pb);
    if (first || __ballot(!(sum <= 65536.f)) != 0ull) {
        float t = fmaxf(sa[0], sb[0]);
#pragma unroll
        for (int i = 1; i < 16; ++i) t = fmaxf(t, fmaxf(sa[i], sb[i]));
        t = fmaxf(t, xor32(t));
        const float delta = first ? t : fmaxf(t, 0.f);
        const float al = first ? 1.f : ex2(-delta);
        m += delta; l *= al; Oa = Oa * al; Ob = Ob * al;
#pragma unroll
        for (int i = 0; i < 16; ++i) { sa[i] -= delta; sb[i] -= delta; }
        sum = exp_sum(sa, sb, pa, pb);
    }
    l += sum;
    u32x4 w;
    w.x = pk2(pa[0], pa[1]); w.y = pk2(pa[2], pa[3]); w.z = pk2(pa[4], pa[5]); w.w = pk2(pa[6], pa[7]); p[0] = __builtin_bit_cast(bf16x8, w);
    w.x = pk2(pa[8], pa[9]); w.y = pk2(pa[10], pa[11]); w.z = pk2(pa[12], pa[13]); w.w = pk2(pa[14], pa[15]); p[1] = __builtin_bit_cast(bf16x8, w);
    w.x = pk2(pb[0], pb[1]); w.y = pk2(pb[2], pb[3]); w.z = pk2(pb[4], pb[5]); w.w = pk2(pb[6], pb[7]); p[2] = __builtin_bit_cast(bf16x8, w);
    w.x = pk2(pb[8], pb[9]); w.y = pk2(pb[10], pb[11]); w.z = pk2(pb[12], pb[13]); w.w = pk2(pb[14], pb[15]); p[3] = __builtin_bit_cast(bf16x8, w);
}
DI bf16x8 ldsv(const LAS unsigned char* p) { const s16x4 lo = *(const LAS s16x4*)p, hi = *(const LAS s16x4*)(p + 16); return __builtin_shufflevector(lo, hi, 0, 1, 2, 3, 4, 5, 6, 7); }

constexpr int DKB = 9216, DBUF = 17920;
DI void diff_item(const Args& A, int l, int b, int h, int qb, LAS unsigned char* lds, const int tid) {
    const int lane = tid & 63, wid = tid >> 6, lh = lane >> 5, ln = lane & 31;
    const bf16_t* Q = (const bf16_t*)(A.ws + WS_DFQ); const bf16_t* K = (const bf16_t*)(A.ws + WS_DFK);
    const bf16_t* VT = (const bf16_t*)(A.ws + WS_DFVT) + (size_t)(b * 256 + h * 64) * KV;
    const int qrow = (qb >= 0 ? b * 4096 + qb * 256 : ML + b * 256) + wid * 32 + ln;
    const bf16_t* qp = Q + (size_t)qrow * 256 + h * 64 + 8 * lh;
    const bf16x8 q1a = ldg8(qp), q1b = ldg8(qp + 16), q2a = ldg8(qp + 32), q2b = ldg8(qp + 48);
    const int lk = tid >> 3, lc = tid & 7;
    const bf16_t* kgL = K + (size_t)(b * 4096 + lk) * 256 + h * 64 + lc * 8;
    const bf16_t* kgC = K + (size_t)(ML + b * 256 + lk) * 256 + h * 64 + lc * 8;
    const bf16_t* vg = VT + (size_t)lk * KV + lc * 8;
    LAS unsigned char* kw = lds + lk * 144 + lc * 16;
    LAS unsigned char* vw = lds + DKB + lk * 136 + lc * 16;
    const LAS unsigned char* kr = lds + ln * 144 + lh * 16;
    const LAS unsigned char* vr = lds + DKB + ln * 136 + lh * 8;
    const int st0 = qb >= 0 ? 0 : 64;
    f32x16 O1a = zero16(), O1b = zero16(), O2a = zero16(), O2b = zero16();
    float m1 = 0.f, l1 = 0.f, m2 = 0.f, l2 = 0.f;
    __syncthreads();
    {
        const bf16x8 kreg = ldg8(st0 < 64 ? kgL + (size_t)st0 * 64 * 256 : kgC + (size_t)(st0 - 64) * 64 * 256);
        const bf16x8 vreg = ldg8(vg + st0 * 64);
        *(LAS bf16x8*)kw = kreg;
        const u32x4 vv = __builtin_bit_cast(u32x4, vreg);
        *(LAS u32x2*)vw = (u32x2){vv.x, vv.y}; *(LAS u32x2*)(vw + 8) = (u32x2){vv.z, vv.w};
    }
    __syncthreads();
    for (int st = st0; st < 68; ++st) {
        const int cur = (st - st0) & 1; const bool more = st + 1 < 68, first = st == st0;
        bf16x8 kreg, vreg;
        if (more) { const int sn = st + 1; kreg = ldg8(sn < 64 ? kgL + (size_t)sn * 64 * 256 : kgC + (size_t)(sn - 64) * 64 * 256); vreg = ldg8(vg + sn * 64); }
        const LAS unsigned char* kb = kr + cur * DBUF; const LAS unsigned char* vb = vr + cur * DBUF;
        f32x16 ng1, ng2; { const float n1 = -m1, n2 = -m2;
#pragma unroll
          for (int i = 0; i < 16; ++i) { ng1[i] = n1; ng2[i] = n2; } }
        f32x16 s1a = MFMA32(*(const LAS bf16x8*)(kb), q1a, ng1); s1a = MFMA32(*(const LAS bf16x8*)(kb + 32), q1b, s1a);
        f32x16 s1b = MFMA32(*(const LAS bf16x8*)(kb + 32 * 144), q1a, ng1); s1b = MFMA32(*(const LAS bf16x8*)(kb + 32 * 144 + 32), q1b, s1b);
        f32x16 s2a = MFMA32(*(const LAS bf16x8*)(kb + 64), q2a, ng2); s2a = MFMA32(*(const LAS bf16x8*)(kb + 96), q2b, s2a);
        f32x16 s2b = MFMA32(*(const LAS bf16x8*)(kb + 32 * 144 + 64), q2a, ng2); s2b = MFMA32(*(const LAS bf16x8*)(kb + 32 * 144 + 96), q2b, s2b);
        bf16x8 p[4], r[4];
        smax64(s1a, s1b, m1, l1, O1a, O1b, first, p);
#pragma unroll
        for (int j = 0; j < 2; ++j) {
            O1a = MFMA32(ldsv(vb + 64 * j), p[2 * j], O1a); O1a = MFMA32(ldsv(vb + 64 * j + 32), p[2 * j + 1], O1a);
            O1b = MFMA32(ldsv(vb + 32 * 136 + 64 * j), p[2 * j], O1b); O1b = MFMA32(ldsv(vb + 32 * 136 + 64 * j + 32), p[2 * j + 1], O1b);
        }
        smax64(s2a, s2b, m2, l2, O2a, O2b, first, r);
#pragma unroll
        for (int j = 0; j < 2; ++j) {
            O2a = MFMA32(ldsv(vb + 64 * j), r[2 * j], O2a); O2a = MFMA32(ldsv(vb + 64 * j + 32), r[2 * j + 1], O2a);
            O2b = MFMA32(ldsv(vb + 32 * 136 + 64 * j), r[2 * j], O2b); O2b = MFMA32(ldsv(vb + 32 * 136 + 64 * j + 32), r[2 * j + 1], O2b);
        }
        if (more) {
            *(LAS bf16x8*)(kw + (cur ^ 1) * DBUF) = kreg;
            const u32x4 vv = __builtin_bit_cast(u32x4, vreg);
            *(LAS u32x2*)(vw + (cur ^ 1) * DBUF) = (u32x2){vv.x, vv.y}; *(LAS u32x2*)(vw + (cur ^ 1) * DBUF + 8) = (u32x2){vv.z, vv.w};
        }
        __syncthreads();
    }
    l1 += xor32(l1); l2 += xor32(l2);
    const float* lt = (const float*)(A.ws + WS_LAM);
    const float i1 = 1.f / l1, i2 = lt[2 * l] / l2, oml = lt[2 * l + 1];
    float ss = 0.f;
#pragma unroll
    for (int i = 0; i < 16; ++i) { O1a[i] = O1a[i] * i1 - O2a[i] * i2; O1b[i] = O1b[i] * i1 - O2b[i] * i2; ss += O1a[i] * O1a[i] + O1b[i] * O1b[i]; }
    ss += xor32(ss);
    const float rn = rsqrtf(ss * (1.f / 64.f) + 1e-6f) * oml;
    const float* g = A.in[19] + l * 64;
    bf16_t* Y = (bf16_t*)(A.ws + WS_H) + (size_t)qrow * 1024 + 768 + h * 64;
#pragma unroll
    for (int ig = 0; ig < 4; ++ig) {
        const int d = 8 * ig + 4 * lh;
        const f32x4 ga = *(const f32x4*)(g + d), gb = *(const f32x4*)(g + 32 + d);
        u32x2 wa, wb;
        wa.x = pk2(O1a[4 * ig] * rn * ga.x, O1a[4 * ig + 1] * rn * ga.y); wa.y = pk2(O1a[4 * ig + 2] * rn * ga.z, O1a[4 * ig + 3] * rn * ga.w);
        wb.x = pk2(O1b[4 * ig] * rn * gb.x, O1b[4 * ig + 1] * rn * gb.y); wb.y = pk2(O1b[4 * ig + 2] * rn * gb.z, O1b[4 * ig + 3] * rn * gb.w);
        *(u32x2*)(Y + d) = wa; *(u32x2*)(Y + 32 + d) = wb;
    }
}

DI void na_item(const Args& A, int l, int b, int h, int rb, LAS unsigned char* lds, LAS float* rpb_s, const int tid) {
    const int lane = tid & 63, wid = __builtin_amdgcn_readfirstlane(tid >> 6), lh = lane >> 5, ln = lane & 31;
    __syncthreads();
    for (int i = tid; i < 465; i += 512) rpb_s[i] = A.in[10][(l * 4 + h) * 465 + i] * LOG2E;
    const bf16_t* Q = (const bf16_t*)(A.ws + WS_NAQ); const bf16_t* K = (const bf16_t*)(A.ws + WS_NAK);
    const bf16_t* VT = (const bf16_t*)(A.ws + WS_NAVT) + (size_t)(b * 256 + h * 64) * KV;
    const bool lat = rb >= 0;
    const int r = rb * 4 + (wid >> 1), qc = (wid & 1) * 32 + ln;
    const int qrow = lat ? b * 4096 + r * 64 + qc : ML + b * 256 + wid * 32 + ln;
    const bf16_t* qp = Q + (size_t)qrow * 256 + h * 64 + 8 * lh;
    const bf16x8 q0 = ldg8(qp), q1 = ldg8(qp + 16), q2 = ldg8(qp + 32), q3 = ldg8(qp + 48);
    const int rs = min(max(r - 4, 0), 56), cs = min(max(qc - 8, 0), 48);
    const int rmin = lat ? min(max(4 * rb - 4, 0), 56) : 0;
    const int nloc = lat ? min(max(4 * rb - 1, 0), 56) + 8 - rmin : 0;
    const int nst = nloc + 4;
    const int lk = tid >> 3, lc = tid & 7;
    const bf16_t* kgL = K + (size_t)(b * 4096 + rmin * 64 + lk) * 256 + h * 64 + lc * 8;
    const bf16_t* kgC = K + (size_t)(ML + b * 256 + lk) * 256 + h * 64 + lc * 8;
    const bf16_t* vg = VT + (size_t)lk * KV + lc * 8;
    LAS unsigned char* kw = lds + lk * 144 + lc * 16;
    LAS unsigned char* vw = lds + DKB + lk * 136 + lc * 16;
    const LAS unsigned char* kr = lds + ln * 144 + lh * 16;
    const LAS unsigned char* vr = lds + DKB + ln * 136 + lh * 8;
    f32x16 Oa = zero16(), Ob = zero16(); float m = 0.f, ls = 0.f; bool started = false;
    {
        const bf16x8 kreg = ldg8(nloc > 0 ? kgL : kgC);
        const bf16x8 vreg = ldg8(vg + (nloc > 0 ? rmin * 64 : 4096));
        *(LAS bf16x8*)kw = kreg;
        const u32x4 vv = __builtin_bit_cast(u32x4, vreg);
        *(LAS u32x2*)vw = (u32x2){vv.x, vv.y}; *(LAS u32x2*)(vw + 8) = (u32x2){vv.z, vv.w};
    }
    __syncthreads();
    for (int j = 0; j < nst; ++j) {
        const int cur = j & 1; const bool more = j + 1 < nst;
        bf16x8 kreg, vreg;
        if (more) { const int jn = j + 1; kreg = ldg8(jn < nloc ? kgL + (size_t)jn * 64 * 256 : kgC + (size_t)(jn - nloc) * 64 * 256); vreg = ldg8(vg + (jn < nloc ? (rmin + jn) * 64 : 4096 + (jn - nloc) * 64)); }
        const bool loc = j < nloc; const int krow = rmin + j;
        if (!loc || (krow >= rs && krow < rs + 8)) {
            const LAS unsigned char* kb = kr + cur * DBUF; const LAS unsigned char* vb = vr + cur * DBUF;
            f32x16 sa = MFMA32(*(const LAS bf16x8*)(kb), q0, zero16()); sa = MFMA32(*(const LAS bf16x8*)(kb + 32), q1, sa);
            sa = MFMA32(*(const LAS bf16x8*)(kb + 64), q2, sa); sa = MFMA32(*(const LAS bf16x8*)(kb + 96), q3, sa);
            f32x16 sb = MFMA32(*(const LAS bf16x8*)(kb + 32 * 144), q0, zero16()); sb = MFMA32(*(const LAS bf16x8*)(kb + 32 * 144 + 32), q1, sb);
            sb = MFMA32(*(const LAS bf16x8*)(kb + 32 * 144 + 64), q2, sb); sb = MFMA32(*(const LAS bf16x8*)(kb + 32 * 144 + 96), q3, sb);
            if (loc) {
                const int dr = krow - r + 7;
#pragma unroll
                for (int i = 0; i < 16; ++i) {
                    const int kc = (i & 3) + 8 * (i >> 2) + 4 * lh;
                    const bool va = kc >= cs && kc < cs + 16, vb2 = kc + 32 >= cs && kc + 32 < cs + 16;
                    const int da = min(max(kc - qc + 15, 0), 30), db = min(max(kc + 32 - qc + 15, 0), 30);
                    sa[i] = va ? sa[i] + rpb_s[dr * 31 + da] - m : -1e30f;
                    sb[i] = vb2 ? sb[i] + rpb_s[dr * 31 + db] - m : -1e30f;
                }
            } else {
#pragma unroll
                for (int i = 0; i < 16; ++i) { sa[i] -= m; sb[i] -= m; }
            }
            bf16x8 p[4];
            smax64(sa, sb, m, ls, Oa, Ob, !started, p); started = true;
#pragma unroll
            for (int jj = 0; jj < 2; ++jj) {
                Oa = MFMA32(ldsv(vb + 64 * jj), p[2 * jj], Oa); Oa = MFMA32(ldsv(vb + 64 * jj + 32), p[2 * jj + 1], Oa);
                Ob = MFMA32(ldsv(vb + 32 * 136 + 64 * jj), p[2 * jj], Ob); Ob = MFMA32(ldsv(vb + 32 * 136 + 64 * jj + 32), p[2 * jj + 1], Ob);
            }
        }
        if (more) {
            *(LAS bf16x8*)(kw + (cur ^ 1) * DBUF) = kreg;
            const u32x4 vv = __builtin_bit_cast(u32x4, vreg);
            *(LAS u32x2*)(vw + (cur ^ 1) * DBUF) = (u32x2){vv.x, vv.y}; *(LAS u32x2*)(vw + (cur ^ 1) * DBUF + 8) = (u32x2){vv.z, vv.w};
        }
        __syncthreads();
    }
    ls += xor32(ls);
    const float inv = 1.f / ls;
    bf16_t* Y = (bf16_t*)(A.ws + WS_H) + (size_t)qrow * 1024 + 256 + h * 64;
#pragma unroll
    for (int ig = 0; ig < 4; ++ig) {
        const int d = 8 * ig + 4 * lh;
        u32x2 wa, wb;
        wa.x = pk2(Oa[4 * ig] * inv, Oa[4 * ig + 1] * inv); wa.y = pk2(Oa[4 * ig + 2] * inv, Oa[4 * ig + 3] * inv);
        wb.x = pk2(Ob[4 * ig] * inv, Ob[4 * ig + 1] * inv); wb.y = pk2(Ob[4 * ig + 2] * inv, Ob[4 * ig + 3] * inv);
        *(u32x2*)(Y + d) = wa; *(u32x2*)(Y + 32 + d) = wb;
    }
}

DI void smax32(f32x16& sa, float& m, float& l, f32x16& Oa, f32x16& Ob, bool& started, bf16x8 (&p)[2]) {
    f32x16 pa; f32x2 s2 = {0.f, 0.f};
#pragma unroll
    for (int i = 0; i < 16; i += 2) { pa[i] = ex2(sa[i]); pa[i + 1] = ex2(sa[i + 1]); s2 += (f32x2){pa[i], pa[i + 1]}; }
    float sum = s2.x + s2.y;
    if (__ballot(!(sum <= 65536.f) || !started) != 0ull) {
        float t = sa[0];
#pragma unroll
        for (int i = 1; i < 16; ++i) t = fmaxf(t, sa[i]);
        t = fmaxf(t, xor32(t));
        const bool has = t > -1e29f;
        const float delta = started ? fmaxf(t, 0.f) : (has ? t : 0.f);
        const float al = started ? ex2(-delta) : 1.f;
        m += delta; l *= al; Oa = Oa * al; Ob = Ob * al;
        started = started || has;
        s2 = (f32x2){0.f, 0.f};
#pragma unroll
        for (int i = 0; i < 16; i += 2) { pa[i] = ex2(sa[i] - delta); pa[i + 1] = ex2(sa[i + 1] - delta); s2 += (f32x2){pa[i], pa[i + 1]}; }
        sum = s2.x + s2.y;
    }
    l += sum;
    u32x4 w;
    w.x = pk2(pa[0], pa[1]); w.y = pk2(pa[2], pa[3]); w.z = pk2(pa[4], pa[5]); w.w = pk2(pa[6], pa[7]); p[0] = __builtin_bit_cast(bf16x8, w);
    w.x = pk2(pa[8], pa[9]); w.y = pk2(pa[10], pa[11]); w.z = pk2(pa[12], pa[13]); w.w = pk2(pa[14], pa[15]); p[1] = __builtin_bit_cast(bf16x8, w);
}

DI void na_item_lat(const Args& A, int l, int b, int h, int rb, LAS unsigned char* lds, LAS float* rpb_s, const int tid) {
    const int lane = tid & 63, wid = __builtin_amdgcn_readfirstlane(tid >> 6), lh = lane >> 5, ln = lane & 31;
    __syncthreads();
    for (int i = tid; i < 465; i += 512) rpb_s[i] = A.in[10][(l * 4 + h) * 465 + i] * LOG2E;
    const bf16_t* Q = (const bf16_t*)(A.ws + WS_NAQ); const bf16_t* K = (const bf16_t*)(A.ws + WS_NAK);
    const bf16_t* VT = (const bf16_t*)(A.ws + WS_NAVT) + (size_t)(b * 256 + h * 64) * KV;
    const int ra = rb * 4 + 2 * (wid >> 2), jg = wid & 3;
    const int r = ra + (ln >> 4), qc = 16 * jg + (ln & 15);
    const int qrow = b * 4096 + r * 64 + qc;
    const bf16_t* qp = Q + (size_t)qrow * 256 + h * 64 + 8 * lh;
    const bf16x8 q0 = ldg8(qp), q1 = ldg8(qp + 16), q2 = ldg8(qp + 32), q3 = ldg8(qp + 48);
    const int rsl = min(max(r - 4, 0), 56), cs = min(max(qc - 8, 0), 48);
    const int w0 = min(max(ra - 4, 0), 56), w1 = min(max(ra - 3, 0), 56) + 8;
    const int t0 = min(max(16 * jg - 8, 0), 32);
    unsigned cmask = 0u;
#pragma unroll
    for (int i = 0; i < 16; ++i) { const int kc = t0 + (i & 3) + 8 * (i >> 2) + 4 * lh; cmask |= (kc >= cs && kc < cs + 16) ? (1u << i) : 0u; }
    const int cbase = t0 + 4 * lh - qc + 15;
    const int rmin = min(max(4 * rb - 4, 0), 56);
    const int nloc = min(max(4 * rb - 1, 0), 56) + 8 - rmin;
    const int nst = nloc + 4;
    const int lk = tid >> 3, lc = tid & 7;
    const bf16_t* kgL = K + (size_t)(b * 4096 + rmin * 64 + lk) * 256 + h * 64 + lc * 8;
    const bf16_t* kgC = K + (size_t)(ML + b * 256 + lk) * 256 + h * 64 + lc * 8;
    const bf16_t* vg = VT + (size_t)lk * KV + lc * 8;
    LAS unsigned char* kw = lds + lk * 144 + lc * 16;
    LAS unsigned char* vw = lds + DKB + lk * 136 + lc * 16;
    const LAS unsigned char* kr = lds + ln * 144 + lh * 16;
    const LAS unsigned char* vr = lds + DKB + ln * 136 + lh * 8;
    f32x16 Oa = zero16(), Ob = zero16(); float m = 0.f, ls = 0.f; bool started = false;
#define NA_KSRC(jn) ((jn) < nloc ? kgL + (size_t)(jn) * 64 * 256 : kgC + (size_t)((jn) - nloc) * 64 * 256)
#define NA_VSRC(jn) (vg + ((jn) < nloc ? (rmin + (jn)) * 64 : 4096 + ((jn) - nloc) * 64))
    bf16x8 kA, vA, kB, vB;
    {
        const bf16x8 kreg = ldg8(NA_KSRC(0));
        const bf16x8 vreg = ldg8(NA_VSRC(0));
        kA = ldg8(NA_KSRC(1)); vA = ldg8(NA_VSRC(1));
        *(LAS bf16x8*)kw = kreg;
        const u32x4 vv = __builtin_bit_cast(u32x4, vreg);
        *(LAS u32x2*)vw = (u32x2){vv.x, vv.y}; *(LAS u32x2*)(vw + 8) = (u32x2){vv.z, vv.w};
    }
    kB = kA; vB = vA;
    __syncthreads();
    for (int j = 0; j < nst; ++j) {
        const int cur = j & 1; const bool more = j + 1 < nst;
        if (j + 2 < nst) { kB = ldg8(NA_KSRC(j + 2)); vB = ldg8(NA_VSRC(j + 2)); }
        const bool loc = j < nloc; const int krow = rmin + j;
        const LAS unsigned char* kb = kr + cur * DBUF; const LAS unsigned char* vb = vr + cur * DBUF;
        if (loc) {
            if (krow >= w0 && krow < w1) {
                const LAS unsigned char* kt = kb + t0 * 144; const LAS unsigned char* vt = vb + t0 * 2;
                f32x16 sa = MFMA32(*(const LAS bf16x8*)(kt), q0, zero16()); sa = MFMA32(*(const LAS bf16x8*)(kt + 32), q1, sa);
                sa = MFMA32(*(const LAS bf16x8*)(kt + 64), q2, sa); sa = MFMA32(*(const LAS bf16x8*)(kt + 96), q3, sa);
                const bool rv = krow >= rsl && krow < rsl + 8;
                const LAS float* rp = rpb_s + ((krow - r + 7) * 31 + cbase);
#pragma unroll
                for (int i = 0; i < 16; ++i) sa[i] = (rv && ((cmask >> i) & 1u)) ? sa[i] + rp[(i & 3) + 8 * (i >> 2)] - m : -1e30f;
                bf16x8 p[2];
                smax32(sa, m, ls, Oa, Ob, started, p);
                Oa = MFMA32(ldsv(vt), p[0], Oa); Oa = MFMA32(ldsv(vt + 32), p[1], Oa);
                Ob = MFMA32(ldsv(vt + 32 * 136), p[0], Ob); Ob = MFMA32(ldsv(vt + 32 * 136 + 32), p[1], Ob);
            }
        } else {
            f32x16 sa = MFMA32(*(const LAS bf16x8*)(kb), q0, zero16()); sa = MFMA32(*(const LAS bf16x8*)(kb + 32), q1, sa);
            sa = MFMA32(*(const LAS bf16x8*)(kb + 64), q2, sa); sa = MFMA32(*(const LAS bf16x8*)(kb + 96), q3, sa);
            f32x16 sb = MFMA32(*(const LAS bf16x8*)(kb + 32 * 144), q0, zero16()); sb = MFMA32(*(const LAS bf16x8*)(kb + 32 * 144 + 32), q1, sb);
            sb = MFMA32(*(const LAS bf16x8*)(kb + 32 * 144 + 64), q2, sb); sb = MFMA32(*(const LAS bf16x8*)(kb + 32 * 144 + 96), q3, sb);
#pragma unroll
            for (int i = 0; i < 16; ++i) { sa[i] -= m; sb[i] -= m; }
            bf16x8 p[4];
            smax64(sa, sb, m, ls, Oa, Ob, false, p);
#pragma unroll
            for (int jj = 0; jj < 2; ++jj) {
                Oa = MFMA32(ldsv(vb + 64 * jj), p[2 * jj], Oa); Oa = MFMA32(ldsv(vb + 64 * jj + 32), p[2 * jj + 1], Oa);
                Ob = MFMA32(ldsv(vb + 32 * 136 + 64 * jj), p[2 * jj], Ob); Ob = MFMA32(ldsv(vb + 32 * 136 + 64 * jj + 32), p[2 * jj + 1], Ob);
            }
        }
        if (more) {
            *(LAS bf16x8*)(kw + (cur ^ 1) * DBUF) = kA;
            const u32x4 vv = __builtin_bit_cast(u32x4, vA);
            *(LAS u32x2*)(vw + (cur ^ 1) * DBUF) = (u32x2){vv.x, vv.y}; *(LAS u32x2*)(vw + (cur ^ 1) * DBUF + 8) = (u32x2){vv.z, vv.w};
        }
        __syncthreads();
        kA = kB; vA = vB;
    }
#undef NA_KSRC
#undef NA_VSRC
    ls += xor32(ls);
    const float inv = 1.f / ls;
    bf16_t* Y = (bf16_t*)(A.ws + WS_H) + (size_t)qrow * 1024 + 256 + h * 64;
#pragma unroll
    for (int ig = 0; ig < 4; ++ig) {
        const int d = 8 * ig + 4 * lh;
        u32x2 wa, wb;
        wa.x = pk2(Oa[4 * ig] * inv, Oa[4 * ig + 1] * inv); wa.y = pk2(Oa[4 * ig + 2] * inv, Oa[4 * ig + 3] * inv);
        wb.x = pk2(Ob[4 * ig] * inv, Ob[4 * ig + 1] * inv); wb.y = pk2(Ob[4 * ig + 2] * inv, Ob[4 * ig + 3] * inv);
        *(u32x2*)(Y + d) = wa; *(u32x2*)(Y + 32 + d) = wb;
    }
}

DI void sgu_item(const Args& A, int l, int ci, LAS unsigned char* lds, const int tid) {
    const int lane = tid & 63, wid = __builtin_amdgcn_readfirstlane(tid >> 6), lh = lane >> 5, ln = lane & 31;
    const int row0 = ci * 128;
    LAS bf16_t* vT = (LAS bf16_t*)lds;
    const bf16_t* SV = (const bf16_t*)(A.ws + WS_SGV); const bf16_t* SU = (const bf16_t*)(A.ws + WS_SGU);
    const f32x4 lg = *(const f32x4*)(A.in[11] + l * 256 + lane * 4), lb = *(const f32x4*)(A.in[12] + l * 256 + lane * 4);
    const int g = wid >> 1, ph = wid & 1;
    bf16x8 bfr[2][8];
    {
        const bf16_t* Wb = (const bf16_t*)(A.ws + WS_SGW) + (size_t)((l * 4 + g) * 128 + 64 * ph + ln) * 128 + 8 * lh;
#pragma unroll
        for (int pt = 0; pt < 2; ++pt)
#pragma unroll
            for (int ks = 0; ks < 8; ++ks) bfr[pt][ks] = ldg8(Wb + (size_t)pt * 32 * 128 + 16 * ks);
    }
    __syncthreads();
#pragma unroll 1
    for (int i4 = 0; i4 < 4; ++i4) {
        const int q0 = wid * 16 + 4 * i4;
        float x[4][4], mu[4], var[4];
#pragma unroll
        for (int rr = 0; rr < 4; ++rr) {
            const u32x2 raw = *(const u32x2*)(SV + (size_t)(row0 + q0 + rr) * 256 + lane * 4);
            x[rr][0] = bf2f(raw.x & 0xffffu); x[rr][1] = bf2f(raw.x >> 16); x[rr][2] = bf2f(raw.y & 0xffffu); x[rr][3] = bf2f(raw.y >> 16);
            mu[rr] = x[rr][0] + x[rr][1] + x[rr][2] + x[rr][3];
        }
#pragma unroll
        for (int o = 32; o > 0; o >>= 1)
#pragma unroll
            for (int rr = 0; rr < 4; ++rr) mu[rr] += __shfl_xor(mu[rr], o);
#pragma unroll
        for (int rr = 0; rr < 4; ++rr) {
            mu[rr] *= (1.f / 256.f);
#pragma unroll
            for (int j = 0; j < 4; ++j) x[rr][j] -= mu[rr];
            var[rr] = x[rr][0] * x[rr][0] + x[rr][1] * x[rr][1] + x[rr][2] * x[rr][2] + x[rr][3] * x[rr][3];
        }
#pragma unroll
        for (int o = 32; o > 0; o >>= 1)
#pragma unroll
            for (int rr = 0; rr < 4; ++rr) var[rr] += __shfl_xor(var[rr], o);
        float rn[4];
#pragma unroll
        for (int rr = 0; rr < 4; ++rr) rn[rr] = rsqrtf(var[rr] * (1.f / 256.f) + 1e-6f);
#pragma unroll
        for (int j = 0; j < 4; ++j) {
            const float gj = lg[j], bj = lb[j];
            u32x2 w; w.x = pk2(x[0][j] * rn[0] * gj + bj, x[1][j] * rn[1] * gj + bj); w.y = pk2(x[2][j] * rn[2] * gj + bj, x[3][j] * rn[3] * gj + bj);
            *(LAS u32x2*)(vT + (lane * 4 + j) * 136 + q0) = w;
        }
    }
    __syncthreads();
    f32x16 acc[2][2];
#pragma unroll
    for (int ct = 0; ct < 2; ++ct)
#pragma unroll
        for (int pt = 0; pt < 2; ++pt) acc[ct][pt] = zero16();
#pragma unroll
    for (int ks = 0; ks < 8; ++ks) {
        bf16x8 af[2];
#pragma unroll
        for (int ct = 0; ct < 2; ++ct) af[ct] = *(const LAS bf16x8*)(vT + (g * 64 + 32 * ct + ln) * 136 + 16 * ks + 8 * lh);
#pragma unroll
        for (int ct = 0; ct < 2; ++ct)
#pragma unroll
            for (int pt = 0; pt < 2; ++pt) acc[ct][pt] = MFMA32(af[ct], bfr[pt][ks], acc[ct][pt]);
    }
    bf16_t* Y = (bf16_t*)(A.ws + WS_H);
#pragma unroll
    for (int pt = 0; pt < 2; ++pt) {
        const int p = 64 * ph + 32 * pt + ln;
        const float bias = A.in[14][(l * 4 + g) * 128 + p];
#pragma unroll
        for (int ct = 0; ct < 2; ++ct)
#pragma unroll
            for (int ig = 0; ig < 4; ++ig) {
                const int c = g * 64 + 32 * ct + 8 * ig + 4 * lh;
                const u32x2 raw = *(const u32x2*)(SU + (size_t)(row0 + p) * 256 + c);
                const float u0 = bf2f(raw.x & 0xffffu), u1 = bf2f(raw.x >> 16), u2 = bf2f(raw.y & 0xffffu), u3 = bf2f(raw.y >> 16);
                u32x2 o; o.x = pk2(u0 * (acc[ct][pt][4 * ig] + bias), u1 * (acc[ct][pt][4 * ig + 1] + bias));
                o.y = pk2(u2 * (acc[ct][pt][4 * ig + 2] + bias), u3 * (acc[ct][pt][4 * ig + 3] + bias));
                *(u32x2*)(Y + (size_t)(row0 + p) * 1024 + 512 + c) = o;
            }
    }
}

#define XB_TMO      128
#define XB_XCNT(j)  (256  + 64 * (j))
#define XB_XSUB(j)  (1280 + 64 * (j))
#define XB_XGEN(j)  (2304 + 64 * (j))
#define XB_TOP      3328
#define XB_TOPGEN   3392
#define XCD_BAR_WORDS 3456
#define XB_SPIN_CAP (1u << 18)

__device__ __forceinline__ unsigned xb_ld(unsigned* p)              { return __hip_atomic_load(p, __ATOMIC_RELAXED, __HIP_MEMORY_SCOPE_AGENT); }
__device__ __forceinline__ unsigned xb_add(unsigned* p, unsigned v) { return __hip_atomic_fetch_add(p, v, __ATOMIC_RELAXED, __HIP_MEMORY_SCOPE_AGENT); }
__device__ __forceinline__ unsigned xb_xcc_id() { return (unsigned)__builtin_amdgcn_s_getreg((3 << 11) | 20) & 0xFu; }
#define XB_SPIN(cond, bar) do { unsigned _sp = 0; while (cond) { __builtin_amdgcn_s_sleep(1); \
    if ((++_sp & 255u) == 0u) { if (xb_ld(&(bar)[XB_TMO])) break; if (_sp > XB_SPIN_CAP) { atomicAdd(&(bar)[XB_TMO], 1u); break; } } } } while (0)

struct XcdBarrier {
    unsigned* bar; unsigned x;
    volatile LAS unsigned* st;
};

__device__ __forceinline__ XcdBarrier xcd_barrier_post(unsigned* bar, volatile LAS unsigned* st) {
    XcdBarrier b; b.bar = bar; b.x = xb_xcc_id(); b.st = st;
    if (threadIdx.x == 0) (void)xb_add(&bar[XB_XCNT(b.x)], 1u);
    return b;
}
__device__ __forceinline__ void xcd_barrier_complete(unsigned* bar, unsigned x, unsigned& nloc, unsigned& nx) {
    const unsigned G = gridDim.x * gridDim.y * gridDim.z;
    unsigned sum, cnt, mine, sp = 0u;
    for (;;) {
        sum = 0u; cnt = 0u; mine = 0u;
#pragma unroll
        for (unsigned j = 0; j < 16; ++j) { const unsigned c = xb_ld(&bar[XB_XCNT(j)]); sum += c; cnt += (c > 0u) ? 1u : 0u; mine = (j == x) ? c : mine; }
        if (sum == G) break;
        __builtin_amdgcn_s_sleep(1);
        if ((++sp & 255u) == 0u) { if (xb_ld(&bar[XB_TMO])) break; if (sp > XB_SPIN_CAP) { atomicAdd(&bar[XB_TMO], 1u); break; } }
    }
    nloc = mine > 0u ? mine : 1u; nx = cnt > 0u ? cnt : 1u;
}

__device__ __forceinline__ void xcd_barrier(const XcdBarrier& b) {
    asm volatile("s_waitcnt vmcnt(0)" ::: "memory");
    __syncthreads();
    if (threadIdx.x == 0) {
        unsigned* bar = b.bar;
        __builtin_amdgcn_s_waitcnt(0);
        unsigned nloc = b.st[0], nx = b.st[1];
        if (nloc == 0u) { xcd_barrier_complete(bar, b.x, nloc, nx); b.st[0] = nloc; b.st[1] = nx; }
        const unsigned old = xb_add(&bar[XB_XSUB(b.x)], 1u);
        const unsigned gen = old / nloc;
        if (old + 1u == (gen + 1u) * nloc) {
            __builtin_amdgcn_fence(__ATOMIC_RELEASE, "agent");
            asm volatile("s_waitcnt vmcnt(0)" ::: "memory");
            const unsigned og = xb_add(&bar[XB_TOP], 1u);
            const unsigned tg = og / nx;
            if (og + 1u == (tg + 1u) * nx) xb_add(&bar[XB_TOPGEN], 1u);
            else XB_SPIN(xb_ld(&bar[XB_TOPGEN]) == tg, bar);
            __builtin_amdgcn_fence(__ATOMIC_ACQUIRE, "agent");
            xb_add(&bar[XB_XGEN(b.x)], 1u);
            asm volatile("s_waitcnt vmcnt(0)" ::: "memory");
        } else {
            XB_SPIN(xb_ld(&bar[XB_XGEN(b.x)]) == gen, bar);
            __builtin_amdgcn_fence(__ATOMIC_ACQUIRE, "agent");
            asm volatile("s_waitcnt vmcnt(0)" ::: "memory");
        }
    }
    __syncthreads();
}

DI void phase_mix(const Args& A, int l, LAS unsigned char* lds, int rep) {
    const bool last = l == DEPTH - 1;
    const int nF = 256, nD = 512, nN = 512, nS = last ? 256 : 272, nFc = last ? 0 : 8, nDc = last ? 0 : 32, nNc = last ? 0 : 32;
    const int e0 = nF, e1 = e0 + nD, e2 = e1 + nN, e3 = e2 + nS, e4 = e3 + nFc, e5 = e4 + nDc, e6 = e5 + nNc, e7 = e6 + (last ? 0 : 704);
    unsigned* ctr = (unsigned*)(A.ws + WS_CTL) + l * 64 + rep * 16;
    LAS int* s_item = (LAS int*)(lds + MISC_OFF);
    LAS float* rpb_s = (LAS float*)(lds + RPB_OFF);
    bf16_t* Y = (bf16_t*)(A.ws + WS_H);
    for (;;) {
        __syncthreads();
        if (threadIdx.x == 0) *s_item = (int)atomicAdd(ctr, 1u);
        __syncthreads();
        const int it = *s_item;
        if (it >= e7) break;
        int tid = threadIdx.x; asm volatile("" : "+v"(tid));
#if PROBE_KIND >= 0
        { const int kind = (it < e0 || (it >= e3 && it < e4)) ? 0 : ((it < e1 || (it >= e4 && it < e5)) ? 1 : (it < e3 ? 3 : 2)); if (rep && kind != PROBE_KIND) continue; }
#endif
        if (it < e0 || (it >= e3 && it < e4)) {
            const bool c = it >= e3;
            pg8::Gemm g{(const bf16_t*)(A.ws + (c ? WS_CSC : WS_CS)), (const bf16_t*)(A.ws + (c ? WS_PQTC : WS_PQT)), c ? 256 : 512, c ? 2048 : 32768, 512};
            OneUnit S{{c ? 0 : (it & 1), c ? it - e3 : (it >> 1)}}; EpiFour E{Y, ML, 256, 1.f / 128.f, c ? 1 : 0};
            if (EN_F) pg8::gemm_phase<EpiFour, OneUnit, true, true>(lds, g, S, E, tid);
        } else if (it < e1) { const int j = it - e0; if (EN_D) diff_item(A, l, j >> 6, (j >> 4) & 3, j & 15, lds, tid); }
        else if (it < e2) { const int j = it - e1; if (EN_N) na_item_lat(A, l, j >> 6, (j >> 4) & 3, j & 15, lds, rpb_s, tid); }
        else if (it < e3) { if (EN_S) sgu_item(A, l, it - e2, lds, tid); }
        else if (it < e5) { const int j = it - e4; if (EN_D) diff_item(A, l, j >> 2, j & 3, -1, lds, tid); }
        else if (it < e6) { const int j = it - e5; if (EN_N) na_item(A, l, j >> 2, j & 3, -1, lds, rpb_s, tid); }
        else transpose_tile(A, l + 1, it - e6, lds, tid);
    }
}

constexpr int N_PHASES = 2 + 7 * DEPTH;
__global__ void __launch_bounds__(512, 2) mk_fwd(Args A) {
    extern __shared__ __attribute__((aligned(16))) unsigned char lds_raw[];
    LAS unsigned char* lds = (LAS unsigned char*)lds_raw;
    unsigned char* ws = A.ws;
    float* cx = (float*)(ws + WS_CX);
    const float* MOD = (const float*)(ws + WS_MOD);
    volatile LAS unsigned* bst = (volatile LAS unsigned*)(lds + MISC_OFF + 16);
    if (threadIdx.x == 0) { bst[0] = 0u; bst[1] = 0u; }
    __syncthreads();
    const XcdBarrier bar = xcd_barrier_post((unsigned*)(ws + WS_CTL) + 1024, bst);
    for (int ph = A.ph_lo; ph < A.ph_hi; ++ph) {
        if (ph > A.ph_lo) { if (A.ph_lo < 0) cg::this_grid().sync(); else xcd_barrier(bar); }
        int tid = threadIdx.x; asm volatile("" : "+v"(tid));
        if (ph == 0) { if (EN_P) phase_prologue(A, lds, tid);
#if PROBE_P0
            xcd_barrier(bar); tid = threadIdx.x; asm volatile("" : "+v"(tid)); phase_prologue(A, lds, tid, PROBE_P0);
#endif
            continue; }
        if (ph == N_PHASES - 1) {
#if PROBE_SYNC
            for (int q = 0; q < 32; ++q) xcd_barrier(bar);
#endif
            phase_final(A, tid); continue; }
        const int l = (ph - 1) / 7, s = (ph - 1) % 7; const bool last = l == DEPTH - 1;
        const float* xl = l == 0 ? A.in[0] : A.out;
        const int Mrows = last ? ML : MT;
        const float* mod = MOD + (size_t)l * 9 * 6144;
#if PROBE_S >= 0
        for (int rep = 0; rep < ((s == PROBE_S) ? 2 : 1); ++rep) {
        if (rep) { xcd_barrier(bar); tid = threadIdx.x; asm volatile("" : "+v"(tid)); }
#else
        { const int rep = 0;
#endif
        if (s == 0) phase_norm(A, l, 0, MT, xl, cx, l > 0 ? MOD + (size_t)((l - 1) * 9 + 8) * 6144 + 5 * 1024 : nullptr, tid);
        else if (s == 1) {
            LAS float* rope = (LAS float*)(lds + ROPE_OFF);
            { const int i = tid, pos = i >> 3, f = i & 7; const float ang = (float)pos * exp2f(-(float)f * (13.287712379549449f / 8.f));
              float t = ang * 0.15915494309189535f; t -= floorf(t); rope[2 * i] = __builtin_amdgcn_cosf(t); rope[2 * i + 1] = __builtin_amdgcn_sinf(t); }
            __syncthreads();
            pg8::Gemm g{(const bf16_t*)(ws + WS_H), (const bf16_t*)(ws + WS_WIN) + (size_t)l * NIN * 1024, MT, NIN, 1024};
            pg8::StaticOrder S; S.init(MT, NIN, gridDim.x, blockIdx.x); EpiIn E{ws, rope};
            if (EN_I) pg8::gemm_phase<EpiIn, pg8::StaticOrder, true, true>(lds, g, S, E, tid);
        } else if (s == 2) phase_mix(A, l, lds, rep);
        else if (s == 3 || s == 6) {
            const bool o = s == 3;
            const bf16_t* Aop = (const bf16_t*)(ws + (o ? WS_H : WS_U));
            const bf16_t* Bop = o ? (const bf16_t*)(ws + WS_WOUT) + (size_t)l * 1024 * 1024 : (const bf16_t*)(ws + WS_WFF2) + (size_t)l * 1024 * 4096;
            const int Kf = o ? 1024 : 4096;
            if (!last) {
                const int ksh = o ? 9 : 11;
                pg8::Gemm g2{Aop, Bop, MT, 1024, Kf / 4, Kf};
                SplitOrder S2{ksh, (int)gridDim.x, (int)blockIdx.x}; EpiPartial E2{(float*)(ws + WS_PB), ksh};
                pg8::gemm_phase<EpiPartial, SplitOrder, true, true>(lds, g2, S2, E2, tid);
                tid = threadIdx.x; asm volatile("" : "+v"(tid));
            }
            pg8::Gemm g{Aop, Bop, ML, 1024, Kf, Kf};
            pg8::StaticOrder S; S.init(ML, 1024, gridDim.x, blockIdx.x); EpiRes E{o ? xl : A.out, cx, A.out, cx, mod + (o ? 2 : 5) * 1024};
            if (EN_R) pg8::gemm_phase<EpiRes, pg8::StaticOrder, true, true>(lds, g, S, E, tid);
        } else if (s == 4) phase_norm(A, l, 1, Mrows, A.out, cx, mod + 8 * 6144 + 2 * 1024, tid);
        else if (s == 5) {
            pg8::Gemm g{(const bf16_t*)(ws + WS_H), (const bf16_t*)(ws + WS_WFF1) + (size_t)l * 4096 * 1024, Mrows, 4096, 1024};
            pg8::StaticOrder S; S.init(Mrows, 4096, gridDim.x, blockIdx.x); EpiFF1 E{(bf16_t*)(ws + WS_U)};
            if (EN_1) pg8::gemm_phase<EpiFF1, pg8::StaticOrder, true, true>(lds, g, S, E, tid);
        }
        }
    }
}

extern "C" void kernel_launch(void* const* d_in, const int* in_sizes, int n_in, void* d_out, int out_size, void* d_ws, size_t ws_size, hipStream_t stream) {
    static int grid = 0;
    if (grid == 0) {
        if (n_in != 23 || in_sizes[0] != ML * DM || out_size != ML * DM || ws_size < WS_END) {
            fprintf(stderr, "kernel_launch: unexpected shapes: n_in %d in0 %d out %d ws %zu (need %zu)\n", n_in, n_in > 0 ? in_sizes[0] : -1, out_size, ws_size, (size_t)WS_END); grid = -1; return; }
        int dev = 0, cus = 0, per_cu = 0;
        (void)hipGetDevice(&dev); (void)hipDeviceGetAttribute(&cus, hipDeviceAttributeMultiprocessorCount, dev);
        if (hipFuncSetAttribute((const void*)mk_fwd, hipFuncAttributeMaxDynamicSharedMemorySize, LDS_BYTES) != hipSuccess) { fprintf(stderr, "kernel_launch: hipFuncSetAttribute failed\n"); grid = -1; return; }
        if (hipOccupancyMaxActiveBlocksPerMultiprocessor(&per_cu, (const void*)mk_fwd, 512, LDS_BYTES) != hipSuccess || per_cu < 1) { fprintf(stderr, "kernel_launch: occupancy query gave %d\n", per_cu); per_cu = 1; }
        (void)hipGetLastError();
        grid = cus * per_cu;
    }
    if (grid < 0) return;
    (void)hipMemsetAsync((char*)d_ws + WS_CTL, 0, 32768, stream);
    Args a{};
    for (int i = 0; i < 23; ++i) a.in[i] = (const float*)d_in[i];
    a.out = (float*)d_out; a.ws = (unsigned char*)d_ws;
#if ONE_LAUNCH
    a.ph_lo = 0; a.ph_hi = N_PHASES;
    void* args[] = {&a};
    hipError_t e = hipLaunchCooperativeKernel((const void*)mk_fwd, dim3(grid), dim3(512), args, LDS_BYTES, stream);
    if (e != hipSuccess) fprintf(stderr, "kernel_launch: cooperative launch failed: %s (grid %d)\n", hipGetErrorString(e), grid);
#else
    for (int ph = 0; ph < N_PHASES; ++ph) { a.ph_lo = ph; a.ph_hi = ph + 1; hipLaunchKernelGGL(mk_fwd, dim3(grid), dim3(512), LDS_BYTES, stream, a); }
#endif
}
```
